# Optimizing an MI355X kernel written in HIP

```python
import math
import jax, jax.numpy as jnp
from jax import lax
import numpy as np

D_MODEL = 1024
BATCH = 8
SEQ = 2048
DEPTH = 1

CHUNK = 64
MIX_WIDTH = D_MODEL
RET_WIDTH = MIX_WIDTH // 2
RET_HEADS = 4
RET_HEAD_DIM = RET_WIDTH // RET_HEADS
GMLP_WIDTH = MIX_WIDTH - RET_WIDTH
GMLP_GROUPS = 4
GMLP_GROUP_DIM = GMLP_WIDTH // GMLP_GROUPS
GMLP_BLOCK = 128
IN_COLS = 4 * RET_WIDTH + 2 * GMLP_WIDTH
ROPE_BASE = 10000.0
MEM_TOKENS = 256
MEM_HEADS = 4
MEM_HEAD_DIM = D_MODEL // MEM_HEADS
N_EXPERTS = 256
TOP_K = 8
N_GROUPS = 8
TOPK_GROUPS = 4
EXPERT_HIDDEN = D_MODEL // 4
SHARED_HIDDEN = EXPERT_HIDDEN
ROUTED_SCALE = 2.5
EXPERT_BLOCK = 128
LN_EPS = 1e-5
DEEPNORM_ALPHA = (2.0 * DEPTH) ** 0.25
DEEPNORM_BETA = (8.0 * DEPTH) ** -0.25

kernel_name = 'hybrid_retention_gmlp_moe_deepnorm'


def _layer_norm(x, g, b):
    xf = x.astype(jnp.float32)
    mu = xf.mean(-1, keepdims=True)
    var = jnp.square(xf - mu).mean(-1, keepdims=True)
    return ((xf - mu) * lax.rsqrt(var + LN_EPS) * g.astype(jnp.float32) + b.astype(jnp.float32)).astype(x.dtype)


def _head_norm(y, g):
    yf = y.astype(jnp.float32)
    mu = yf.mean(-1, keepdims=True)
    var = jnp.square(yf - mu).mean(-1, keepdims=True)
    return ((yf - mu) * lax.rsqrt(var + LN_EPS) * g.astype(jnp.float32)).astype(y.dtype)


def _rotary(t, positions):
    half = t.shape[-1] // 2
    inv = ROPE_BASE ** (-jnp.arange(half, dtype=jnp.float32) / half)
    ang = positions.astype(jnp.float32)[..., None] * inv
    cos = jnp.cos(ang)[:, :, None, :].astype(t.dtype)
    sin = jnp.sin(ang)[:, :, None, :].astype(t.dtype)
    t1, t2 = t[..., :half], t[..., half:]
    return jnp.concatenate([t1 * cos - t2 * sin, t1 * sin + t2 * cos], axis=-1)


def _retention(q, k, v, positions):
    B, S, H, Dh = q.shape
    NC = S // CHUNK
    dt = q.dtype
    q = _rotary(q, positions)
    k = _rotary(k, positions) * (Dh ** -0.5)
    gamma = 1.0 - 2.0 ** (-5.0 - jnp.arange(H, dtype=jnp.float32))
    log_g = jnp.log(gamma)
    idx = jnp.arange(CHUNK, dtype=jnp.float32)
    intra_decay = jnp.exp(log_g[:, None, None] * jnp.abs(idx[:, None] - idx[None, :])).astype(dt)
    zeta = jnp.exp(log_g[:, None] * (CHUNK - 1 - idx)[None, :]).astype(dt)
    xi = jnp.exp(log_g[:, None] * (idx + 1.0)[None, :]).astype(dt)
    chunk_decay = jnp.exp(log_g * CHUNK).astype(dt)
    qc = q.reshape(B, NC, CHUNK, H, Dh)
    kc = k.reshape(B, NC, CHUNK, H, Dh)
    vc = v.reshape(B, NC, CHUNK, H, Dh)
    scores = jnp.einsum('bnihd,bnjhd->bnhij', qc, kc) * intra_decay[None, None]
    intra = jnp.einsum('bnhij,bnjhd->bnihd', scores, vc)
    upd = jnp.einsum('bnjhk,bnjhv,hj->nbhkv', kc, vc, zeta)

    def step(state, u):
        new = (state * chunk_decay[None, :, None, None] + u).astype(state.dtype)
        return new, state

    _, prev = lax.scan(step, jnp.zeros((B, H, Dh, Dh), dt), upd)
    inter = jnp.einsum('bnihk,nbhkv,hi->bnihv', qc, prev, xi)
    return (intra + inter).reshape(B, S, H, Dh)


def _spatial_gating(u, v, ln_g, ln_b, w_s, b_s):
    B, S, _ = u.shape
    NB = S // GMLP_BLOCK
    u = jax.nn.gelu(u, approximate=False)
    v = jax.nn.gelu(v, approximate=False)
    v = _layer_norm(v.reshape(B, S, GMLP_GROUPS, GMLP_GROUP_DIM),
                    ln_g.reshape(GMLP_GROUPS, GMLP_GROUP_DIM), ln_b.reshape(GMLP_GROUPS, GMLP_GROUP_DIM))
    cpos = jnp.arange(GMLP_BLOCK) // CHUNK
    mask = cpos[None, :] <= cpos[:, None]
    ws = jnp.where(mask[None], w_s, jnp.zeros_like(w_s))
    vb = v.reshape(B, NB, GMLP_BLOCK, GMLP_GROUPS, GMLP_GROUP_DIM)
    s = jnp.einsum('gij,bnjgc->bnigc', ws, vb) + b_s.T[None, None, :, :, None]
    out = u.reshape(B, NB, GMLP_BLOCK, GMLP_GROUPS, GMLP_GROUP_DIM) * s
    return out.reshape(B, S, GMLP_WIDTH)


def _hybrid_mixer(x, positions, w_in, ret_gn_g, gmlp_ln_g, gmlp_ln_b, gmlp_ws, gmlp_bs, w_out):
    B, S, _ = x.shape
    z = x @ w_in
    R, G = RET_WIDTH, GMLP_WIDTH
    q, k, v, gate, u, vg = jnp.split(z, [R, 2 * R, 3 * R, 4 * R, 4 * R + G], axis=-1)
    shp = (B, S, RET_HEADS, RET_HEAD_DIM)
    ret = _retention(q.reshape(shp), k.reshape(shp), v.reshape(shp), positions)
    ret = _head_norm(ret, ret_gn_g.reshape(RET_HEADS, RET_HEAD_DIM)).reshape(B, S, RET_WIDTH)
    ret = jax.nn.silu(gate) * ret
    sgu = _spatial_gating(u, vg, gmlp_ln_g, gmlp_ln_b, gmlp_ws, gmlp_bs)
    return jnp.concatenate([ret, sgu], axis=-1) @ w_out


def _memory_attention(x, mem, wq, wkv, wo):
    B, S, D = x.shape
    M = mem.shape[1]
    q = (x @ wq).reshape(B, S, MEM_HEADS, MEM_HEAD_DIM)
    k, v = jnp.split(mem @ wkv, 2, axis=-1)
    k = k.reshape(B, M, MEM_HEADS, MEM_HEAD_DIM)
    v = v.reshape(B, M, MEM_HEADS, MEM_HEAD_DIM)
    logits = jnp.einsum('bshd,bmhd->bhsm', q, k).astype(jnp.float32) * (MEM_HEAD_DIM ** -0.5)
    p = jax.nn.softmax(logits, axis=-1).astype(x.dtype)
    o = jnp.einsum('bhsm,bmhd->bshd', p, v).reshape(B, S, D)
    return o @ wo


def _route(xt, router_w, router_bias):
    N = xt.shape[0]
    scores = jax.nn.sigmoid((xt @ router_w).astype(jnp.float32))
    biased = scores + router_bias.astype(jnp.float32)
    per_group = N_EXPERTS // N_GROUPS
    grp = biased.reshape(N, N_GROUPS, per_group)
    grp_score = lax.top_k(grp, 2)[0].sum(-1)
    _, gidx = lax.top_k(grp_score, TOPK_GROUPS)
    gmask = jnp.any(gidx[..., None] == jnp.arange(N_GROUPS)[None, None, :], axis=1)
    emask = jnp.repeat(gmask, per_group, axis=-1)
    masked = jnp.where(emask, biased, -jnp.inf)
    _, eidx = lax.top_k(masked, TOP_K)
    sel = jnp.take_along_axis(scores, eidx, axis=-1)
    gates = sel / sel.sum(-1, keepdims=True) * ROUTED_SCALE
    return eidx.astype(jnp.int32), gates.astype(xt.dtype)


def _moe(x, router_w, router_bias, w_gate, w_up, w_down, sh_gate, sh_up, sh_down):
    B, S, D = x.shape
    N = B * S
    xt = x.reshape(N, D)
    eidx, gates = _route(xt, router_w, router_bias)
    NK = N * TOP_K
    n_blocks = -(-(NK + N_EXPERTS * (EXPERT_BLOCK - 1)) // EXPERT_BLOCK)
    P = n_blocks * EXPERT_BLOCK
    flat_e = eidx.reshape(NK)
    flat_tok = jnp.repeat(jnp.arange(N, dtype=jnp.int32), TOP_K)
    flat_g = gates.reshape(NK)
    order = jnp.argsort(flat_e, stable=True)
    se, stok, sg = flat_e[order], flat_tok[order], flat_g[order]
    counts = jax.ops.segment_sum(jnp.ones((NK,), jnp.int32), flat_e, num_segments=N_EXPERTS)
    starts = jnp.cumsum(counts) - counts
    pcounts = (counts + EXPERT_BLOCK - 1) // EXPERT_BLOCK * EXPERT_BLOCK
    pends = jnp.cumsum(pcounts)
    pstarts = pends - pcounts
    dest = pstarts[se] + (jnp.arange(NK, dtype=jnp.int32) - starts[se])
    buf_tok = jnp.zeros((P,), jnp.int32).at[dest].set(stok)
    buf_g = jnp.zeros((P,), x.dtype).at[dest].set(sg)
    block_e = jnp.clip(jnp.searchsorted(pends, jnp.arange(n_blocks, dtype=jnp.int32) * EXPERT_BLOCK, side='right'),
                       0, N_EXPERTS - 1).astype(jnp.int32)

    def body(y, blk):
        tok, g, e = blk
        xb = xt[tok]
        h = jax.nn.silu(xb @ w_gate[e]) * (xb @ w_up[e])
        o = (h @ w_down[e]) * g[:, None]
        return y.at[tok].add(o.astype(y.dtype)), None

    routed, _ = lax.scan(body, jnp.zeros_like(xt),
                         (buf_tok.reshape(n_blocks, EXPERT_BLOCK), buf_g.reshape(n_blocks, EXPERT_BLOCK), block_e))
    shared = (jax.nn.silu(xt @ sh_gate) * (xt @ sh_up)) @ sh_down
    return (routed + shared).reshape(B, S, D)


def setup_inputs(seed: int = 0) -> dict:
    key = jax.random.key(seed)
    ks = jax.random.split(key, 32)
    L, D, E, H = DEPTH, D_MODEL, N_EXPERTS, EXPERT_HIDDEN
    f32 = jnp.float32

    def nrm(k, shape, scale):
        return jax.random.normal(k, shape, f32) * scale

    def gain(k, shape):
        return 1.0 + 0.02 * jax.random.normal(k, shape, f32)

    positions = (jax.random.randint(ks[2], (BATCH, 1), 0, 4096, dtype=jnp.int32)
                 + jnp.arange(SEQ, dtype=jnp.int32)[None, :])
    return {
        'x': jax.random.normal(ks[0], (BATCH, SEQ, D), f32),
        'mem': jax.random.normal(ks[1], (BATCH, MEM_TOKENS, D), f32),
        'positions': positions,
        'w_in': nrm(ks[3], (L, D, IN_COLS), D ** -0.5),
        'ret_gn_g': gain(ks[4], (L, RET_WIDTH)),
        'gmlp_ln_g': gain(ks[5], (L, GMLP_WIDTH)),
        'gmlp_ln_b': nrm(ks[6], (L, GMLP_WIDTH), 0.02),
        'gmlp_ws': nrm(ks[7], (L, GMLP_GROUPS, GMLP_BLOCK, GMLP_BLOCK), GMLP_BLOCK ** -0.5),
        'gmlp_bs': gain(ks[8], (L, GMLP_GROUPS, GMLP_BLOCK)),
        'w_out': nrm(ks[9], (L, MIX_WIDTH, D), DEEPNORM_BETA * MIX_WIDTH ** -0.5),
        'ln1_g': gain(ks[10], (L, D)),
        'ln1_b': nrm(ks[11], (L, D), 0.02),
        'ca_wq': nrm(ks[12], (L, D, D), D ** -0.5),
        'ca_wkv': nrm(ks[13], (L, D, 2 * D), D ** -0.5),
        'ca_wo': nrm(ks[14], (L, D, D), DEEPNORM_BETA * D ** -0.5),
        'ln2_g': gain(ks[15], (L, D)),
        'ln2_b': nrm(ks[16], (L, D), 0.02),
        'router_w': nrm(ks[17], (L, D, E), D ** -0.5),
        'router_bias': nrm(ks[18], (L, E), 0.01),
        'exp_w_gate': nrm(ks[19], (L, E, D, H), D ** -0.5),
        'exp_w_up': nrm(ks[20], (L, E, D, H), D ** -0.5),
        'exp_w_down': nrm(ks[21], (L, E, H, D), DEEPNORM_BETA * H ** -0.5),
        'sh_w_gate': nrm(ks[22], (L, D, SHARED_HIDDEN), D ** -0.5),
        'sh_w_up': nrm(ks[23], (L, D, SHARED_HIDDEN), D ** -0.5),
        'sh_w_down': nrm(ks[24], (L, SHARED_HIDDEN, D), DEEPNORM_BETA * SHARED_HIDDEN ** -0.5),
        'ln3_g': gain(ks[25], (L, D)),
        'ln3_b': nrm(ks[26], (L, D), 0.02),
    }


def reference(x, mem, positions, w_in, ret_gn_g, gmlp_ln_g, gmlp_ln_b, gmlp_ws, gmlp_bs, w_out,
              ln1_g, ln1_b, ca_wq, ca_wkv, ca_wo, ln2_g, ln2_b, router_w, router_bias,
              exp_w_gate, exp_w_up, exp_w_down, sh_w_gate, sh_w_up, sh_w_down, ln3_g, ln3_b):
    for l in range(DEPTH):
        mix = _hybrid_mixer(x, positions, w_in[l], ret_gn_g[l], gmlp_ln_g[l], gmlp_ln_b[l],
                            gmlp_ws[l], gmlp_bs[l], w_out[l])
        x = _layer_norm(DEEPNORM_ALPHA * x + mix, ln1_g[l], ln1_b[l])
        ca = _memory_attention(x, mem, ca_wq[l], ca_wkv[l], ca_wo[l])
        x = _layer_norm(DEEPNORM_ALPHA * x + ca, ln2_g[l], ln2_b[l])
        ff = _moe(x, router_w[l], router_bias[l], exp_w_gate[l], exp_w_up[l], exp_w_down[l],
                  sh_w_gate[l], sh_w_up[l], sh_w_down[l])
        x = _layer_norm(DEEPNORM_ALPHA * x + ff, ln3_g[l], ln3_b[l])
    return x
```

```cpp
#include <hip/hip_runtime.h>
#include <cstdio>
#include <cstdint>

constexpr int BATCH = 8, SEQ = 2048, D = 1024, M = BATCH * SEQ;
constexpr int NZ = 3072;
constexpr int MEMT = 256, MROWS = BATCH * MEMT;
constexpr int NE = 256, TOPK = 8, EH = 256;
constexpr int ECAP = 16384;
constexpr int HB_ROWS = M * TOPK + NE * 256;
constexpr float LN_EPS = 1e-5f;
constexpr float ALPHA = 1.189207115002721f;
constexpr float ROUTED_SCALE = 2.5f;

constexpr size_t MiB = 1u << 20;
constexpr size_t WS_CTL = 0, CTL_ZERO_BYTES = 1 * MiB;
constexpr size_t WS_W1T = 1 * MiB;
constexpr size_t WS_W2T = 257 * MiB;
constexpr size_t WS_WINT = 385 * MiB;
constexpr size_t WS_WOUTT = 391 * MiB, WS_WQT = 393 * MiB, WS_WKVT = 395 * MiB, WS_WOT = 399 * MiB;
constexpr size_t WS_WRT = 401 * MiB;
constexpr size_t WS_WSH1T = 402 * MiB;
constexpr size_t WS_WSH2T = 403 * MiB;
constexpr size_t WS_WSM = 404 * MiB;
constexpr size_t WS_MEMB = 405 * MiB;
constexpr size_t WS_COS = 409 * MiB, WS_SIN = 413 * MiB;
constexpr size_t WS_KVM = 417 * MiB;
constexpr size_t WS_X2 = 425 * MiB;
constexpr size_t WS_SC = 457 * MiB;
constexpr size_t WS_HS = 473 * MiB;
constexpr size_t WS_YS = 481 * MiB;
constexpr size_t WS_HB = 513 * MiB;
constexpr size_t WS_LIST = 609 * MiB;
constexpr size_t WS_EIDX = 625 * MiB;
constexpr size_t WS_GATE = 625 * MiB + 512 * 1024;
constexpr size_t WS_T32 = 626 * MiB;
constexpr size_t WS_OB = 690 * MiB;
constexpr size_t WS_XB = 690 * MiB, WS_Z = 722 * MiB, WS_MIX = 818 * MiB, WS_X1 = 850 * MiB, WS_QC = 882 * MiB, WS_OC = 914 * MiB;
constexpr size_t WS_END = 946 * MiB;
static_assert((size_t)HB_ROWS * EH * 2 <= 96 * MiB, "HB");
constexpr int CW_CNT = 65536;

typedef unsigned short bf16;
typedef unsigned v4u __attribute__((ext_vector_type(4)));
typedef unsigned v2u __attribute__((ext_vector_type(2)));
typedef float f32x4 __attribute__((ext_vector_type(4)));

__device__ __forceinline__ float bf2f(bf16 b) { return __uint_as_float(((unsigned)b) << 16); }
__device__ __forceinline__ unsigned f2bf(float f) { unsigned u = __float_as_uint(f); return (u + 0x7fffu + ((u >> 16) & 1u)) >> 16; }
__device__ __forceinline__ unsigned pk2(float lo, float hi) { return f2bf(lo) | (f2bf(hi) << 16); }
__device__ __forceinline__ float lo16(unsigned w) { return __uint_as_float(w << 16); }
__device__ __forceinline__ float hi16(unsigned w) { return __uint_as_float(w & 0xffff0000u); }
__device__ __forceinline__ float wave_sum(float v) {
#pragma unroll
    for (int o = 1; o < 64; o <<= 1) v += __shfl_xor(v, o);
    return v;
}
__device__ __forceinline__ float silu_f(float v) { return v / (1.f + __expf(-v)); }
__device__ __forceinline__ float gelu_f(float v) { return 0.5f * v * (1.f + erff(v * 0.70710678118654752f)); }
__device__ __forceinline__ float head_log2g(int h) { return log2f(1.f - exp2f(-5.f - (float)h)); }

struct Ptrs {
    const float *x, *mem; const int* pos;
    const float *w_in, *ret_gn_g, *gmlp_ln_g, *gmlp_ln_b, *gmlp_ws, *gmlp_bs, *w_out, *ln1_g, *ln1_b, *ca_wq, *ca_wkv, *ca_wo, *ln2_g, *ln2_b;
    const float *router_w, *router_bias, *exp_w_gate, *exp_w_up, *exp_w_down, *sh_w_gate, *sh_w_up, *sh_w_down, *ln3_g, *ln3_b;
    float* out; unsigned char* ws;
};

__device__ __forceinline__ int dest_row(int mode, int n) {
    if (mode == 1) { if (n < 1024) { const int d = n & 127; return (n & ~127) + 8 * ((d & 63) >> 2) + 4 * (d >> 6) + (d & 3); } return n; }
    if (mode == 2) return ((n >> 7) << 8) + (n & 127);
    if (mode == 3) return ((n >> 7) << 8) + 128 + (n & 127);
    return n;
}
__device__ __forceinline__ void transpose_item(const float* W, int K, int N, bf16* WT, int mode, float* scr, int item, int lane) {
    const int nblk = N / 32, kb = item / nblk, nb = item % nblk, k0 = 64 * kb, n0 = 32 * nb;
#pragma unroll 8
    for (int i = 0; i < 32; ++i) { const int kk = 2 * i + (lane >> 5); scr[kk * 33 + (lane & 31)] = W[(size_t)(k0 + kk) * N + n0 + (lane & 31)]; }
    asm volatile("s_waitcnt lgkmcnt(0)" ::: "memory");
    const int c = lane & 7;
#pragma unroll
    for (int j = 0; j < 4; ++j) { const int n = (lane >> 3) + 8 * j; const float* s = scr + (8 * c) * 33 + n;
        v4u o; o.x = pk2(s[0 * 33], s[1 * 33]); o.y = pk2(s[2 * 33], s[3 * 33]); o.z = pk2(s[4 * 33], s[5 * 33]); o.w = pk2(s[6 * 33], s[7 * 33]);
        *(v4u*)(WT + (size_t)dest_row(mode, n0 + n) * K + k0 + 8 * c) = o; }
    asm volatile("s_waitcnt lgkmcnt(0)" ::: "memory");
}
__device__ __forceinline__ void prologue_all(const Ptrs& P, int gw, int NGW, int lane, float* scr) {
    unsigned char* ws = P.ws;
    {
        constexpr int I_IN = (1024 / 64) * (3072 / 32), I_SQ = (1024 / 64) * (1024 / 32), I_KV = (1024 / 64) * (2048 / 32), I_R = (1024 / 64) * (256 / 32), I_D = (256 / 64) * (1024 / 32);
        constexpr int NIT = I_IN + 3 * I_SQ + I_KV + I_R + 2 * I_R + I_D;
        for (int it = gw; it < NIT; it += NGW) {
            int r = it;
            if (r < I_IN) { transpose_item(P.w_in, 1024, 3072, (bf16*)(ws + WS_WINT), 1, scr, r, lane); continue; } r -= I_IN;
            if (r < I_SQ) { transpose_item(P.w_out, 1024, 1024, (bf16*)(ws + WS_WOUTT), 0, scr, r, lane); continue; } r -= I_SQ;
            if (r < I_SQ) { transpose_item(P.ca_wq, 1024, 1024, (bf16*)(ws + WS_WQT), 0, scr, r, lane); continue; } r -= I_SQ;
            if (r < I_SQ) { transpose_item(P.ca_wo, 1024, 1024, (bf16*)(ws + WS_WOT), 0, scr, r, lane); continue; } r -= I_SQ;
            if (r < I_KV) { transpose_item(P.ca_wkv, 1024, 2048, (bf16*)(ws + WS_WKVT), 0, scr, r, lane); continue; } r -= I_KV;
            if (r < I_R) { transpose_item(P.router_w, 1024, 256, (bf16*)(ws + WS_WRT), 0, scr, r, lane); continue; } r -= I_R;
            if (r < I_R) { transpose_item(P.sh_w_gate, 1024, 256, (bf16*)(ws + WS_WSH1T), 2, scr, r, lane); continue; } r -= I_R;
            if (r < I_R) { transpose_item(P.sh_w_up, 1024, 256, (bf16*)(ws + WS_WSH1T), 3, scr, r, lane); continue; } r -= I_R;
            transpose_item(P.sh_w_down, 256, 1024, (bf16*)(ws + WS_WSH2T), 0, scr, r, lane);
        }
    }
    {
        constexpr int PER = 128;
        for (int it = gw; it < NE * 3 * PER; it += NGW) {
            const int e = it / (3 * PER), r = it % (3 * PER);
            if (r < PER) transpose_item(P.exp_w_gate + (size_t)e * 1024 * 256, 1024, 256, (bf16*)(ws + WS_W1T) + (size_t)e * 512 * 1024, 2, scr, r, lane);
            else if (r < 2 * PER) transpose_item(P.exp_w_up + (size_t)e * 1024 * 256, 1024, 256, (bf16*)(ws + WS_W1T) + (size_t)e * 512 * 1024, 3, scr, r - PER, lane);
            else transpose_item(P.exp_w_down + (size_t)e * 256 * 1024, 256, 1024, (bf16*)(ws + WS_W2T) + (size_t)e * 1024 * 256, 0, scr, r - 2 * PER, lane);
        }
    }
    {
        const size_t nx8 = (size_t)M * D / 8, nm8 = (size_t)MROWS * D / 8;
        for (size_t i = (size_t)gw * 64 + lane; i < nx8 + nm8; i += (size_t)NGW * 64) {
            const bool isx = i < nx8; const size_t j = isx ? i : i - nx8;
            const f32x4* s = (const f32x4*)((isx ? P.x : P.mem) + j * 8); const f32x4 a = s[0], b = s[1];
            v4u o; o.x = pk2(a.x, a.y); o.y = pk2(a.z, a.w); o.z = pk2(b.x, b.y); o.w = pk2(b.z, b.w);
            *(v4u*)((bf16*)(ws + (isx ? WS_XB : WS_MEMB)) + j * 8) = o;
        }
    }
    {
        float* ct = (float*)(ws + WS_COS); float* st = (float*)(ws + WS_SIN);
        for (size_t i = (size_t)gw * 64 + lane; i < (size_t)M * 64; i += (size_t)NGW * 64) {
            const int m = (int)(i >> 6), d = (int)(i & 63);
            const float inv = exp2f(-(float)d * (13.287712379549449f / 64.f));
            const float ang = (float)P.pos[m] * inv; float s, c; sincosf(ang, &s, &c);
            ct[i] = c; st[i] = s;
        }
    }
    {
        bf16* wm = (bf16*)(ws + WS_WSM);
        for (int i = gw * 64 + lane; i < 4 * 128 * 128; i += NGW * 64) { const int ii = (i >> 7) & 127, jj = i & 127; wm[i] = (bf16)(((jj >> 6) <= (ii >> 6)) ? f2bf(P.gmlp_ws[i]) : 0u); }
    }
}
__global__ void __launch_bounds__(256) k_prologue(Ptrs P) {
    __shared__ float scr[4][64 * 33];
    const int wave = threadIdx.x >> 6, lane = threadIdx.x & 63;
    prologue_all(P, blockIdx.x * 4 + wave, gridDim.x * 4, lane, scr[wave]);
}

__device__ __forceinline__ v4u epi_z8(const unsigned char* ws, int m, int c0, const float (&v)[8]) {
    const int sec = c0 >> 9; float o[8];
    if (sec < 2) {
        const int h = (c0 >> 7) & 3, dd0 = ((c0 & 127) >> 3) * 4, il = m & 63;
        const f32x4 cs = *(const f32x4*)((const float*)(ws + WS_COS) + (size_t)m * 64 + dd0), sn = *(const f32x4*)((const float*)(ws + WS_SIN) + (size_t)m * 64 + dd0);
        const float l2g = head_log2g(h);
        const float sc = sec == 0 ? exp2f(l2g * (float)(il + 1)) : 0.08838834764831845f * exp2f(l2g * (float)(63 - il));
#pragma unroll
        for (int t = 0; t < 4; ++t) { const float t1 = v[t], t2 = v[4 + t]; o[t] = (t1 * cs[t] - t2 * sn[t]) * sc; o[4 + t] = (t1 * sn[t] + t2 * cs[t]) * sc; }
    } else if (sec == 2) {
#pragma unroll
        for (int t = 0; t < 8; ++t) o[t] = v[t];
    } else if (sec == 3) {
#pragma unroll
        for (int t = 0; t < 8; ++t) o[t] = silu_f(v[t]);
    } else {
#pragma unroll
        for (int t = 0; t < 8; ++t) o[t] = gelu_f(v[t]);
    }
    v4u w; w.x = pk2(o[0], o[1]); w.y = pk2(o[2], o[3]); w.z = pk2(o[4], o[5]); w.w = pk2(o[6], o[7]); return w;
}

template <int NB, class Prob>
__global__ void __launch_bounds__(256) nv_gemm(Prob pr, int K) {
    __shared__ float As[16][68]; __shared__ float Bs[NB][16][132];
    if (!pr.setup()) return;
    const int t = threadIdx.x, tx = t & 15, ty = t >> 4;
    const int m0 = blockIdx.y * 64, n0 = blockIdx.x * 128;
    float acc[4][8], acc2[4][8];
#pragma unroll
    for (int i = 0; i < 4; ++i)
#pragma unroll
        for (int j = 0; j < 8; ++j) { acc[i][j] = 0.f; acc2[i][j] = 0.f; }
    const bf16* ap = pr.arow(m0 + (t >> 2)) + (t & 3) * 4;
    const bf16* bp = pr.brow(n0 + (t >> 1)) + (t & 1) * 8;
    const bf16* bp2 = NB == 2 ? pr.brow2(n0 + (t >> 1)) + (t & 1) * 8 : bp;
    for (int k0 = 0; k0 < K; k0 += 16) {
        const v2u a = *(const v2u*)(ap + k0); const v4u b = *(const v4u*)(bp + k0);
        { const int r = t >> 2, kk = (t & 3) * 4; As[kk][r] = lo16(a.x); As[kk + 1][r] = hi16(a.x); As[kk + 2][r] = lo16(a.y); As[kk + 3][r] = hi16(a.y); }
        { const int r = t >> 1, kk = (t & 1) * 8; Bs[0][kk][r] = lo16(b.x); Bs[0][kk + 1][r] = hi16(b.x); Bs[0][kk + 2][r] = lo16(b.y); Bs[0][kk + 3][r] = hi16(b.y);
          Bs[0][kk + 4][r] = lo16(b.z); Bs[0][kk + 5][r] = hi16(b.z); Bs[0][kk + 6][r] = lo16(b.w); Bs[0][kk + 7][r] = hi16(b.w); }
        if (NB == 2) { const v4u c = *(const v4u*)(bp2 + k0); const int r = t >> 1, kk = (t & 1) * 8;
          Bs[NB - 1][kk][r] = lo16(c.x); Bs[NB - 1][kk + 1][r] = hi16(c.x); Bs[NB - 1][kk + 2][r] = lo16(c.y); Bs[NB - 1][kk + 3][r] = hi16(c.y);
          Bs[NB - 1][kk + 4][r] = lo16(c.z); Bs[NB - 1][kk + 5][r] = hi16(c.z); Bs[NB - 1][kk + 6][r] = lo16(c.w); Bs[NB - 1][kk + 7][r] = hi16(c.w); }
        __syncthreads();
#pragma unroll
        for (int kk = 0; kk < 16; ++kk) {
            float av[4], bv[8], cv[8];
#pragma unroll
            for (int i = 0; i < 4; ++i) av[i] = As[kk][ty * 4 + i];
#pragma unroll
            for (int j = 0; j < 8; ++j) { bv[j] = Bs[0][kk][tx * 8 + j]; cv[j] = Bs[NB - 1][kk][tx * 8 + j]; }
#pragma unroll
            for (int i = 0; i < 4; ++i)
#pragma unroll
                for (int j = 0; j < 8; ++j) { acc[i][j] += av[i] * bv[j]; if (NB == 2) acc2[i][j] += av[i] * cv[j]; }
        }
        __syncthreads();
    }
#pragma unroll
    for (int i = 0; i < 4; ++i) pr.epi(m0 + ty * 4 + i, n0 + tx * 8, acc[i], acc2[i]);
}

struct ProbZ {
    const bf16 *A, *Bt; bf16* Z; const unsigned char* ws;
    __device__ bool setup() { return true; }
    __device__ const bf16* arow(int r) const { return A + (size_t)r * 1024; }
    __device__ const bf16* brow(int n) const { return Bt + (size_t)n * 1024; }
    __device__ const bf16* brow2(int n) const { return nullptr; }
    __device__ void epi(int r, int n0, const float (&a)[8], const float (&)[8]) const { *(v4u*)(Z + (size_t)r * NZ + n0) = epi_z8(ws, r, n0, a); }
};
struct ProbBf {
    const bf16 *A, *Bt; int lda, ldb; bf16* C; int ldc, pad;
    __device__ bool setup() { return true; }
    __device__ const bf16* arow(int r) const { return A + (size_t)r * lda; }
    __device__ const bf16* brow(int n) const { return Bt + (size_t)n * ldb; }
    __device__ const bf16* brow2(int n) const { return nullptr; }
    __device__ void epi(int r, int n0, const float (&a)[8], const float (&)[8]) const { v4u w; w.x = pk2(a[0], a[1]); w.y = pk2(a[2], a[3]); w.z = pk2(a[4], a[5]); w.w = pk2(a[6], a[7]); *(v4u*)(C + (size_t)r * ldc + n0) = w; }
};
struct ProbF32 {
    const bf16 *A, *Bt; int lda, ldb; float* C; int ldc; int act;
    __device__ bool setup() { return true; }
    __device__ const bf16* arow(int r) const { return A + (size_t)r * lda; }
    __device__ const bf16* brow(int n) const { return Bt + (size_t)n * ldb; }
    __device__ const bf16* brow2(int n) const { return nullptr; }
    __device__ void epi(int r, int n0, const float (&a)[8], const float (&)[8]) const {
#pragma unroll
        for (int j = 0; j < 8; ++j) C[(size_t)r * ldc + n0 + j] = act ? 1.f / (1.f + __expf(-a[j])) : a[j]; }
};
struct ProbShared {
    const bf16 *A, *Bt; bf16* C;
    __device__ bool setup() { return true; }
    __device__ const bf16* arow(int r) const { return A + (size_t)r * 1024; }
    __device__ const bf16* brow(int n) const { return Bt + (size_t)dest_row(2, n) * 1024; }
    __device__ const bf16* brow2(int n) const { return Bt + (size_t)dest_row(3, n) * 1024; }
    __device__ void epi(int r, int n0, const float (&a)[8], const float (&b)[8]) const { float o[8];
#pragma unroll
        for (int j = 0; j < 8; ++j) o[j] = silu_f(a[j]) * b[j];
        v4u w; w.x = pk2(o[0], o[1]); w.y = pk2(o[2], o[3]); w.z = pk2(o[4], o[5]); w.w = pk2(o[6], o[7]); *(v4u*)(C + (size_t)r * 256 + n0) = w; }
};
__device__ __forceinline__ int padded_base(const unsigned* cnt, int e) { int s = 0; for (int i = 0; i < e; ++i) s += (int)((cnt[i] + 255u) >> 8) << 8; return s; }
struct ProbExpUp {
    const bf16 *X2, *W1T; bf16* HB; const unsigned* cnt; const int* list; int e, n, pb, pad;
    __device__ bool setup() { e = blockIdx.z; n = (int)cnt[e]; if ((int)blockIdx.y * 64 >= n) return false; pb = padded_base(cnt, e); return true; }
    __device__ const bf16* arow(int r) const { const int rr = r < n ? r : 0; return X2 + (size_t)(list[(size_t)e * ECAP + rr] >> 3) * 1024; }
    __device__ const bf16* brow(int nn) const { return W1T + ((size_t)e * 512 + dest_row(2, nn)) * 1024; }
    __device__ const bf16* brow2(int nn) const { return W1T + ((size_t)e * 512 + dest_row(3, nn)) * 1024; }
    __device__ void epi(int r, int n0, const float (&a)[8], const float (&b)[8]) const { float o[8];
#pragma unroll
        for (int j = 0; j < 8; ++j) o[j] = silu_f(a[j]) * b[j];
        v4u w; w.x = pk2(o[0], o[1]); w.y = pk2(o[2], o[3]); w.z = pk2(o[4], o[5]); w.w = pk2(o[6], o[7]); *(v4u*)(HB + (size_t)(pb + r) * 256 + n0) = w; }
};
struct ProbExpDown {
    const bf16 *HB, *W2T; bf16* OB; const unsigned* cnt; const int* list; const float* gate; int e, n, pb, pad;
    __device__ bool setup() { e = blockIdx.z; n = (int)cnt[e]; if ((int)blockIdx.y * 64 >= n) return false; pb = padded_base(cnt, e); return true; }
    __device__ const bf16* arow(int r) const { return HB + (size_t)(pb + r) * 256; }
    __device__ const bf16* brow(int nn) const { return W2T + ((size_t)e * 1024 + nn) * 256; }
    __device__ const bf16* brow2(int nn) const { return nullptr; }
    __device__ void epi(int r, int n0, const float (&a)[8], const float (&)[8]) const { if (r >= n) return; const int tk = list[(size_t)e * ECAP + r]; const float g = gate[tk];
        v4u w; w.x = pk2(a[0] * g, a[1] * g); w.y = pk2(a[2] * g, a[3] * g); w.z = pk2(a[4] * g, a[5] * g); w.w = pk2(a[6] * g, a[7] * g); *(v4u*)(OB + (size_t)tk * 1024 + n0) = w; }
};

__global__ void __launch_bounds__(256) nv_retention(const bf16* Z, bf16* MIX, const float* gn_g) {
    __shared__ float qs[16][128]; __shared__ float sc[16][64];
    const int t = threadIdx.x, h = blockIdx.y, b = blockIdx.z, i0 = blockIdx.x * 16;
    const int ci = i0 >> 6; const size_t rb = (size_t)b * SEQ;
    for (int i = t; i < 16 * 128; i += 256) qs[i >> 7][i & 127] = bf2f(Z[(rb + i0 + (i >> 7)) * NZ + h * 128 + (i & 127)]);
    __syncthreads();
    const float l2g = head_log2g(h);
    const int ii = t >> 4, jq = (t & 15) * 4, dv = (t & 15) * 8;
    float acc[8];
#pragma unroll
    for (int j = 0; j < 8; ++j) acc[j] = 0.f;
    for (int jt = 0; jt <= ci; ++jt) {
#pragma unroll
        for (int jj = 0; jj < 4; ++jj) {
            const bf16* kr = Z + (rb + jt * 64 + jq + jj) * NZ + 512 + h * 128; float s = 0.f;
            for (int d = 0; d < 128; d += 8) { const v4u kv = *(const v4u*)(kr + d);
                s += qs[ii][d] * lo16(kv.x) + qs[ii][d + 1] * hi16(kv.x) + qs[ii][d + 2] * lo16(kv.y) + qs[ii][d + 3] * hi16(kv.y)
                   + qs[ii][d + 4] * lo16(kv.z) + qs[ii][d + 5] * hi16(kv.z) + qs[ii][d + 6] * lo16(kv.w) + qs[ii][d + 7] * hi16(kv.w); }
            float w;
            if (jt < ci) w = exp2f(l2g * 64.f * (float)(ci - 1 - jt));
            else { const int il = (i0 & 63) + ii, jl = jq + jj; w = exp2f(l2g * (float)(jl <= il ? -64 : 2 * (jl - il) - 64)); }
            sc[ii][jq + jj] = s * w;
        }
        __syncthreads();
        for (int j = 0; j < 64; ++j) { const float p = sc[ii][j]; const v4u vv = *(const v4u*)(Z + (rb + jt * 64 + j) * NZ + 1024 + h * 128 + dv);
            acc[0] += p * lo16(vv.x); acc[1] += p * hi16(vv.x); acc[2] += p * lo16(vv.y); acc[3] += p * hi16(vv.y);
            acc[4] += p * lo16(vv.z); acc[5] += p * hi16(vv.z); acc[6] += p * lo16(vv.w); acc[7] += p * hi16(vv.w); }
        __syncthreads();
    }
    float s = 0.f;
#pragma unroll
    for (int j = 0; j < 8; ++j) s += acc[j];
    s += __shfl_xor(s, 1); s += __shfl_xor(s, 2); s += __shfl_xor(s, 4); s += __shfl_xor(s, 8);
    const float mean = s * (1.f / 128.f); float q = 0.f;
#pragma unroll
    for (int j = 0; j < 8; ++j) { const float d = acc[j] - mean; q += d * d; }
    q += __shfl_xor(q, 1); q += __shfl_xor(q, 2); q += __shfl_xor(q, 4); q += __shfl_xor(q, 8);
    const float rstd = 1.f / sqrtf(q * (1.f / 128.f) + LN_EPS);
    const size_t row = rb + i0 + ii; const v4u gt = *(const v4u*)(Z + row * NZ + 1536 + h * 128 + dv);
    const float gg[8] = {lo16(gt.x), hi16(gt.x), lo16(gt.y), hi16(gt.y), lo16(gt.z), hi16(gt.z), lo16(gt.w), hi16(gt.w)}; float o[8];
#pragma unroll
    for (int j = 0; j < 8; ++j) o[j] = (acc[j] - mean) * rstd * gn_g[h * 128 + dv + j] * gg[j];
    v4u w; w.x = pk2(o[0], o[1]); w.y = pk2(o[2], o[3]); w.z = pk2(o[4], o[5]); w.w = pk2(o[6], o[7]);
    *(v4u*)(MIX + row * 1024 + h * 128 + dv) = w;
}
__global__ void __launch_bounds__(256) nv_gmlp(const bf16* Z, bf16* MIX, const bf16* WsM, const float* ln_g, const float* ln_b, const float* bs) {
    __shared__ bf16 vn[128][128];
    const int t = threadIdx.x, g = blockIdx.y, wave = t >> 6, lane = t & 63; const size_t r0 = (size_t)blockIdx.x * 128;
    for (int r = wave * 32; r < wave * 32 + 32; ++r) {
        const unsigned w = *(const unsigned*)(Z + (r0 + r) * NZ + 2560 + g * 128 + lane * 2); const float a = lo16(w), b = hi16(w);
        const float mean = wave_sum(a + b) * (1.f / 128.f); const float da = a - mean, db = b - mean; const float rstd = 1.f / sqrtf(wave_sum(da * da + db * db) * (1.f / 128.f) + LN_EPS);
        const int c = g * 128 + lane * 2;
        *(unsigned*)&vn[r][lane * 2] = pk2(da * rstd * ln_g[c] + ln_b[c], db * rstd * ln_g[c + 1] + ln_b[c + 1]);
    }
    __syncthreads();
    const int i = t & 127, ch = t >> 7; const bf16* wr = WsM + ((size_t)g * 128 + i) * 128; const float bi = bs[g * 128 + i];
    for (int cg = 0; cg < 8; ++cg) { const int c = ch * 64 + cg * 8; float acc[8];
#pragma unroll
        for (int j = 0; j < 8; ++j) acc[j] = 0.f;
        for (int j = 0; j < 128; ++j) { const float w = bf2f(wr[j]); const v4u vv = *(const v4u*)&vn[j][c];
            acc[0] += w * lo16(vv.x); acc[1] += w * hi16(vv.x); acc[2] += w * lo16(vv.y); acc[3] += w * hi16(vv.y);
            acc[4] += w * lo16(vv.z); acc[5] += w * hi16(vv.z); acc[6] += w * lo16(vv.w); acc[7] += w * hi16(vv.w); }
        const v4u uu = *(const v4u*)(Z + (r0 + i) * NZ + 2048 + g * 128 + c);
        const float ug[8] = {lo16(uu.x), hi16(uu.x), lo16(uu.y), hi16(uu.y), lo16(uu.z), hi16(uu.z), lo16(uu.w), hi16(uu.w)}; float o[8];
#pragma unroll
        for (int j = 0; j < 8; ++j) o[j] = ug[j] * (acc[j] + bi);
        v4u w; w.x = pk2(o[0], o[1]); w.y = pk2(o[2], o[3]); w.z = pk2(o[4], o[5]); w.w = pk2(o[6], o[7]);
        *(v4u*)(MIX + (r0 + i) * 1024 + 512 + g * 128 + c) = w; }
}
__global__ void __launch_bounds__(256) nv_xattn(const bf16* QC, const bf16* KVM, bf16* OC) {
    __shared__ float qs[256]; __shared__ float ps[256]; __shared__ float red[8];
    const int t = threadIdx.x, m = blockIdx.x, h = blockIdx.y, b = m / SEQ;
    qs[t] = bf2f(QC[(size_t)m * 1024 + h * 256 + t]);
    __syncthreads();
    const bf16* kr = KVM + ((size_t)b * MEMT + t) * 2048 + h * 256; float s = 0.f;
    for (int d = 0; d < 256; d += 8) { const v4u kv = *(const v4u*)(kr + d);
        s += qs[d] * lo16(kv.x) + qs[d + 1] * hi16(kv.x) + qs[d + 2] * lo16(kv.y) + qs[d + 3] * hi16(kv.y) + qs[d + 4] * lo16(kv.z) + qs[d + 5] * hi16(kv.z) + qs[d + 6] * lo16(kv.w) + qs[d + 7] * hi16(kv.w); }
    s *= 0.0625f;
    float mx = s;
#pragma unroll
    for (int o = 1; o < 64; o <<= 1) mx = fmaxf(mx, __shfl_xor(mx, o));
    if ((t & 63) == 0) red[t >> 6] = mx;
    __syncthreads();
    mx = fmaxf(fmaxf(red[0], red[1]), fmaxf(red[2], red[3]));
    const float p = __expf(s - mx); const float sm = wave_sum(p);
    if ((t & 63) == 0) red[4 + (t >> 6)] = sm;
    ps[t] = p;
    __syncthreads();
    const float inv = 1.f / (red[4] + red[5] + red[6] + red[7]);
    float acc = 0.f;
    for (int j = 0; j < 256; ++j) acc += ps[j] * bf2f(KVM[((size_t)b * MEMT + j) * 2048 + 1024 + h * 256 + t]);
    OC[(size_t)m * 1024 + h * 256 + t] = (bf16)f2bf(acc * inv);
}
__global__ void __launch_bounds__(256) nv_ln(const float* T, const bf16* res, const float* g, const float* bb, bf16* out) {
    const int m = blockIdx.x * 4 + (threadIdx.x >> 6), lane = threadIdx.x & 63;
    f32x4 v[4]; float s = 0.f;
#pragma unroll
    for (int j = 0; j < 4; ++j) { const int c = 4 * lane + 256 * j; const f32x4 a = *(const f32x4*)(T + (size_t)m * 1024 + c); const v2u r = *(const v2u*)(res + (size_t)m * 1024 + c);
        v[j].x = ALPHA * lo16(r.x) + a.x; v[j].y = ALPHA * hi16(r.x) + a.y; v[j].z = ALPHA * lo16(r.y) + a.z; v[j].w = ALPHA * hi16(r.y) + a.w; s += (v[j].x + v[j].y) + (v[j].z + v[j].w); }
    const float mean = wave_sum(s) * (1.f / 1024.f); float q = 0.f;
#pragma unroll
    for (int j = 0; j < 4; ++j) { v[j] = v[j] - mean; q += (v[j].x * v[j].x + v[j].y * v[j].y) + (v[j].z * v[j].z + v[j].w * v[j].w); }
    const float rstd = 1.f / sqrtf(wave_sum(q) * (1.f / 1024.f) + LN_EPS);
#pragma unroll
    for (int j = 0; j < 4; ++j) { const int c = 4 * lane + 256 * j; const f32x4 gg = *(const f32x4*)(g + c), bv = *(const f32x4*)(bb + c);
        v2u o; o.x = pk2(v[j].x * rstd * gg.x + bv.x, v[j].y * rstd * gg.y + bv.y); o.y = pk2(v[j].z * rstd * gg.z + bv.z, v[j].w * rstd * gg.w + bv.w);
        *(v2u*)(out + (size_t)m * 1024 + c) = o; }
}
__device__ __forceinline__ unsigned long long shfl_xor_u64(unsigned long long v, int o) { const unsigned lo = __shfl_xor((unsigned)v, o), hi = __shfl_xor((unsigned)(v >> 32), o); return ((unsigned long long)hi << 32) | lo; }
__device__ __forceinline__ unsigned ford(float f) { const unsigned u = __float_as_uint(f); return (u & 0x80000000u) ? ~u : (u | 0x80000000u); }
__device__ __forceinline__ void route_token(const unsigned char* ws, const float* rbias, int tok, int lane) {
    const float* SC = (const float*)(ws + WS_SC);
    const f32x4 s = *(const f32x4*)(SC + (size_t)tok * 256 + 4 * lane), bi = *(const f32x4*)(rbias + 4 * lane);
    float bv[4] = {s.x + bi.x, s.y + bi.y, s.z + bi.z, s.w + bi.w};
    float m1 = fmaxf(bv[0], bv[1]), m2 = fminf(bv[0], bv[1]);
    { const float c = bv[2]; const float n1 = fmaxf(m1, c); m2 = fmaxf(fminf(m1, c), m2); m1 = n1; }
    { const float c = bv[3]; const float n1 = fmaxf(m1, c); m2 = fmaxf(fminf(m1, c), m2); m1 = n1; }
#pragma unroll
    for (int o = 1; o < 8; o <<= 1) { const float o1 = __shfl_xor(m1, o), o2 = __shfl_xor(m2, o); const float n1 = fmaxf(m1, o1); m2 = fmaxf(fminf(m1, o1), fmaxf(m2, o2)); m1 = n1; }
    const float gs = m1 + m2; const int mygrp = lane >> 3; int rank = 0;
#pragma unroll
    for (int j = 0; j < 8; ++j) { const float o = __shfl(gs, 8 * j); rank += (o > gs || (o == gs && j < mygrp)) ? 1 : 0; }
    const bool sel = rank < 4;
    unsigned long long key[4];
#pragma unroll
    for (int j = 0; j < 4; ++j) key[j] = sel ? (((unsigned long long)ford(bv[j]) << 32) | (unsigned)(255 - (4 * lane + j))) : 0ull;
    int my_e = 0; float my_s = 0.f, ssum = 0.f;
#pragma unroll
    for (int k = 0; k < 8; ++k) {
        unsigned long long best = key[0] > key[1] ? key[0] : key[1]; { const unsigned long long b2 = key[2] > key[3] ? key[2] : key[3]; best = best > b2 ? best : b2; }
#pragma unroll
        for (int o = 1; o < 64; o <<= 1) { const unsigned long long ob = shfl_xor_u64(best, o); best = ob > best ? ob : best; }
        const int e = 255 - (int)(best & 0xffffffffu);
        const float mine = (e & 3) == 0 ? s.x : (e & 3) == 1 ? s.y : (e & 3) == 2 ? s.z : s.w;
        const float se = __shfl(mine, e >> 2);
        ssum += se;
        if (lane == k) { my_e = e; my_s = se; }
#pragma unroll
        for (int j = 0; j < 4; ++j) if (4 * lane + j == e) key[j] = 0ull;
    }
    if (lane < 8) {
        unsigned* cnt = (unsigned*)(ws + WS_CTL) + CW_CNT;
        const unsigned pos = atomicAdd(cnt + my_e, 1u);
        ((int*)(ws + WS_LIST))[(size_t)my_e * ECAP + pos] = tok * 8 + lane;
        ((int*)(ws + WS_EIDX))[tok * 8 + lane] = my_e;
        ((float*)(ws + WS_GATE))[tok * 8 + lane] = my_s / ssum * ROUTED_SCALE;
    }
}
__global__ void __launch_bounds__(256) k_route(const unsigned char* ws, const float* rbias) {
    const int tok = blockIdx.x * 4 + (threadIdx.x >> 6); route_token(ws, rbias, tok, threadIdx.x & 63);
}
__device__ __forceinline__ void combine_token(const unsigned char* ws, const float* g, const float* bb, float* out, int m, int lane) {
    const bf16* X2 = (const bf16*)(ws + WS_X2); const bf16* YS = (const bf16*)(ws + WS_YS); const bf16* OB = (const bf16*)(ws + WS_OB);
    f32x4 v[4]; float s = 0.f;
#pragma unroll
    for (int j = 0; j < 4; ++j) { const int c = 4 * lane + 256 * j; const v2u r = *(const v2u*)(X2 + (size_t)m * 1024 + c), y = *(const v2u*)(YS + (size_t)m * 1024 + c);
        f32x4 a; a.x = ALPHA * lo16(r.x) + lo16(y.x); a.y = ALPHA * hi16(r.x) + hi16(y.x); a.z = ALPHA * lo16(r.y) + lo16(y.y); a.w = ALPHA * hi16(r.y) + hi16(y.y);
#pragma unroll
        for (int k = 0; k < 8; ++k) { const v2u o = *(const v2u*)(OB + ((size_t)m * 8 + k) * 1024 + c); a.x += lo16(o.x); a.y += hi16(o.x); a.z += lo16(o.y); a.w += hi16(o.y); }
        v[j] = a; s += (a.x + a.y) + (a.z + a.w); }
    const float mean = wave_sum(s) * (1.f / 1024.f); float q = 0.f;
#pragma unroll
    for (int j = 0; j < 4; ++j) { v[j] = v[j] - mean; q += (v[j].x * v[j].x + v[j].y * v[j].y) + (v[j].z * v[j].z + v[j].w * v[j].w); }
    const float rstd = 1.f / sqrtf(wave_sum(q) * (1.f / 1024.f) + LN_EPS);
#pragma unroll
    for (int j = 0; j < 4; ++j) { const int c = 4 * lane + 256 * j; const f32x4 gg = *(const f32x4*)(g + c), bv = *(const f32x4*)(bb + c);
        f32x4 o; o.x = v[j].x * rstd * gg.x + bv.x; o.y = v[j].y * rstd * gg.y + bv.y; o.z = v[j].z * rstd * gg.z + bv.z; o.w = v[j].w * rstd * gg.w + bv.w;
        *(f32x4*)(out + (size_t)m * 1024 + c) = o; }
}
__global__ void __launch_bounds__(256) k_combine(const unsigned char* ws, const float* g, const float* bb, float* out) {
    combine_token(ws, g, bb, out, blockIdx.x * 4 + (threadIdx.x >> 6), threadIdx.x & 63);
}

extern "C" void kernel_launch(void* const* d_in, const int* in_sizes, int n_in, void* d_out, int out_size, void* d_ws, size_t ws_size, hipStream_t stream) {
    if (n_in != 27 || in_sizes[0] != M * D || out_size != M * D || ws_size < WS_END) { fprintf(stderr, "kernel_launch: unexpected shapes: n_in %d in0 %d out %d ws %zu (need %zu)\n", n_in, n_in > 0 ? in_sizes[0] : -1, out_size, ws_size, (size_t)WS_END); return; }
    Ptrs P{};
    P.x = (const float*)d_in[0]; P.mem = (const float*)d_in[1]; P.pos = (const int*)d_in[2];
    P.w_in = (const float*)d_in[3]; P.ret_gn_g = (const float*)d_in[4]; P.gmlp_ln_g = (const float*)d_in[5]; P.gmlp_ln_b = (const float*)d_in[6]; P.gmlp_ws = (const float*)d_in[7]; P.gmlp_bs = (const float*)d_in[8];
    P.w_out = (const float*)d_in[9]; P.ln1_g = (const float*)d_in[10]; P.ln1_b = (const float*)d_in[11]; P.ca_wq = (const float*)d_in[12]; P.ca_wkv = (const float*)d_in[13]; P.ca_wo = (const float*)d_in[14];
    P.ln2_g = (const float*)d_in[15]; P.ln2_b = (const float*)d_in[16]; P.router_w = (const float*)d_in[17]; P.router_bias = (const float*)d_in[18];
    P.exp_w_gate = (const float*)d_in[19]; P.exp_w_up = (const float*)d_in[20]; P.exp_w_down = (const float*)d_in[21]; P.sh_w_gate = (const float*)d_in[22]; P.sh_w_up = (const float*)d_in[23]; P.sh_w_down = (const float*)d_in[24];
    P.ln3_g = (const float*)d_in[25]; P.ln3_b = (const float*)d_in[26]; P.out = (float*)d_out; P.ws = (unsigned char*)d_ws;
    unsigned char* ws = (unsigned char*)d_ws;
    (void)hipMemsetAsync(ws + WS_CTL, 0, CTL_ZERO_BYTES, stream);
    bf16 *XB = (bf16*)(ws + WS_XB), *Z = (bf16*)(ws + WS_Z), *MIX = (bf16*)(ws + WS_MIX), *X1 = (bf16*)(ws + WS_X1), *QC = (bf16*)(ws + WS_QC), *OC = (bf16*)(ws + WS_OC), *X2 = (bf16*)(ws + WS_X2);
    bf16 *KVM = (bf16*)(ws + WS_KVM), *MEMB = (bf16*)(ws + WS_MEMB), *HS = (bf16*)(ws + WS_HS), *YS = (bf16*)(ws + WS_YS), *HB = (bf16*)(ws + WS_HB), *OB = (bf16*)(ws + WS_OB);
    float *T32 = (float*)(ws + WS_T32), *SC = (float*)(ws + WS_SC);
    const unsigned* cnt = (const unsigned*)(ws + WS_CTL) + CW_CNT; const int* list = (const int*)(ws + WS_LIST); const float* gate = (const float*)(ws + WS_GATE);
    hipLaunchKernelGGL(k_prologue, dim3(2048), dim3(256), 0, stream, P);
    hipLaunchKernelGGL((nv_gemm<1, ProbZ>), dim3(NZ / 128, M / 64), dim3(256), 0, stream, ProbZ{XB, (const bf16*)(ws + WS_WINT), Z, ws}, 1024);
    hipLaunchKernelGGL((nv_gemm<1, ProbBf>), dim3(2048 / 128, MROWS / 64), dim3(256), 0, stream, ProbBf{MEMB, (const bf16*)(ws + WS_WKVT), 1024, 1024, KVM, 2048, 0}, 1024);
    hipLaunchKernelGGL(nv_retention, dim3(SEQ / 16, 4, BATCH), dim3(256), 0, stream, (const bf16*)Z, MIX, P.ret_gn_g);
    hipLaunchKernelGGL(nv_gmlp, dim3(M / 128, 4), dim3(256), 0, stream, (const bf16*)Z, MIX, (const bf16*)(ws + WS_WSM), P.gmlp_ln_g, P.gmlp_ln_b, P.gmlp_bs);
    hipLaunchKernelGGL((nv_gemm<1, ProbF32>), dim3(1024 / 128, M / 64), dim3(256), 0, stream, ProbF32{MIX, (const bf16*)(ws + WS_WOUTT), 1024, 1024, T32, 1024, 0}, 1024);
    hipLaunchKernelGGL(nv_ln, dim3(M / 4), dim3(256), 0, stream, (const float*)T32, (const bf16*)XB, P.ln1_g, P.ln1_b, X1);
    hipLaunchKernelGGL((nv_gemm<1, ProbBf>), dim3(1024 / 128, M / 64), dim3(256), 0, stream, ProbBf{X1, (const bf16*)(ws + WS_WQT), 1024, 1024, QC, 1024, 0}, 1024);
    hipLaunchKernelGGL(nv_xattn, dim3(M, 4), dim3(256), 0, stream, (const bf16*)QC, (const bf16*)KVM, OC);
    hipLaunchKernelGGL((nv_gemm<1, ProbF32>), dim3(1024 / 128, M / 64), dim3(256), 0, stream, ProbF32{OC, (const bf16*)(ws + WS_WOT), 1024, 1024, T32, 1024, 0}, 1024);
    hipLaunchKernelGGL(nv_ln, dim3(M / 4), dim3(256), 0, stream, (const float*)T32, (const bf16*)X1, P.ln2_g, P.ln2_b, X2);
    hipLaunchKernelGGL((nv_gemm<1, ProbF32>), dim3(256 / 128, M / 64), dim3(256), 0, stream, ProbF32{X2, (const bf16*)(ws + WS_WRT), 1024, 1024, SC, 256, 1}, 1024);
    hipLaunchKernelGGL((nv_gemm<2, ProbShared>), dim3(256 / 128, M / 64), dim3(256), 0, stream, ProbShared{X2, (const bf16*)(ws + WS_WSH1T), HS}, 1024);
    hipLaunchKernelGGL(k_route, dim3(M / 4), dim3(256), 0, stream, (const unsigned char*)ws, P.router_bias);
    hipLaunchKernelGGL((nv_gemm<1, ProbBf>), dim3(1024 / 128, M / 64), dim3(256), 0, stream, ProbBf{HS, (const bf16*)(ws + WS_WSH2T), 256, 256, YS, 1024, 0}, 256);
    hipLaunchKernelGGL((nv_gemm<2, ProbExpUp>), dim3(256 / 128, ECAP / 64, NE), dim3(256), 0, stream, ProbExpUp{X2, (const bf16*)(ws + WS_W1T), HB, cnt, list, 0, 0, 0, 0}, 1024);
    hipLaunchKernelGGL((nv_gemm<1, ProbExpDown>), dim3(1024 / 128, ECAP / 64, NE), dim3(256), 0, stream, ProbExpDown{HB, (const bf16*)(ws + WS_W2T), OB, cnt, list, gate, 0, 0, 0, 0}, 256);
    hipLaunchKernelGGL(k_combine, dim3(M / 4), dim3(256), 0, stream, (const unsigned char*)ws, P.ln3_g, P.ln3_b, (float*)d_out);
}
```

```cpp
#include <hip/hip_runtime.h>
#include <cstdio>
#include <cstdint>

constexpr int BATCH = 8, SEQ = 2048, D = 1024, M = BATCH * SEQ;
constexpr int NZ = 3072;
constexpr int MEMT = 256, MROWS = BATCH * MEMT;
constexpr int NE = 256, TOPK = 8, EH = 256;
constexpr int ECAP = 16384;
constexpr int HB_ROWS = M * TOPK + NE * 256;
constexpr float LN_EPS = 1e-5f;
constexpr float ALPHA = 1.189207115002721f;
constexpr float ROUTED_SCALE = 2.5f;

constexpr size_t MiB = 1u << 20;
constexpr size_t WS_CTL = 0, CTL_ZERO_BYTES = 1 * MiB;
constexpr size_t WS_W1T = 1 * MiB;
constexpr size_t WS_W2T = 257 * MiB;
constexpr size_t WS_WINT = 385 * MiB;
constexpr size_t WS_WOUTT = 391 * MiB, WS_WQT = 393 * MiB, WS_WKVT = 395 * MiB, WS_WOT = 399 * MiB;
constexpr size_t WS_WRT = 401 * MiB;
constexpr size_t WS_WSH1T = 402 * MiB;
constexpr size_t WS_WSH2T = 403 * MiB;
constexpr size_t WS_WSM = 404 * MiB;
constexpr size_t WS_MEMB = 405 * MiB;
constexpr size_t WS_COS = 409 * MiB, WS_SIN = 413 * MiB;
constexpr size_t WS_KVM = 417 * MiB;
constexpr size_t WS_X2 = 425 * MiB;
constexpr size_t WS_SC = 457 * MiB;
constexpr size_t WS_HS = 473 * MiB;
constexpr size_t WS_YS = 481 * MiB;
constexpr size_t WS_HB = 513 * MiB;
constexpr size_t WS_LIST = 609 * MiB;
constexpr size_t WS_EIDX = 625 * MiB;
constexpr size_t WS_GATE = 625 * MiB + 512 * 1024;
constexpr size_t WS_T32 = 626 * MiB;
constexpr size_t WS_OB = 690 * MiB;
constexpr size_t WS_XB = 690 * MiB, WS_Z = 722 * MiB, WS_MIX = 818 * MiB, WS_X1 = 850 * MiB, WS_QC = 882 * MiB, WS_OC = 914 * MiB;
constexpr size_t WS_END = 946 * MiB;
static_assert((size_t)HB_ROWS * EH * 2 <= 96 * MiB, "HB");
constexpr int CW_CNT = 65536;

typedef unsigned short bf16;
typedef unsigned v4u __attribute__((ext_vector_type(4)));
typedef unsigned v2u __attribute__((ext_vector_type(2)));
typedef float f32x4 __attribute__((ext_vector_type(4)));

__device__ __forceinline__ float bf2f(bf16 b) { return __uint_as_float(((unsigned)b) << 16); }
__device__ __forceinline__ unsigned f2bf(float f) { unsigned u = __float_as_uint(f); return (u + 0x7fffu + ((u >> 16) & 1u)) >> 16; }
__device__ __forceinline__ unsigned pk2(float lo, float hi) { return f2bf(lo) | (f2bf(hi) << 16); }
__device__ __forceinline__ float lo16(unsigned w) { return __uint_as_float(w << 16); }
__device__ __forceinline__ float hi16(unsigned w) { return __uint_as_float(w & 0xffff0000u); }
__device__ __forceinline__ float wave_sum(float v) {
#pragma unroll
    for (int o = 1; o < 64; o <<= 1) v += __shfl_xor(v, o);
    return v;
}
__device__ __forceinline__ float silu_f(float v) { return v / (1.f + __expf(-v)); }
__device__ __forceinline__ float gelu_f(float v) { return 0.5f * v * (1.f + erff(v * 0.70710678118654752f)); }
__device__ __forceinline__ float head_log2g(int h) { return log2f(1.f - exp2f(-5.f - (float)h)); }

struct Ptrs {
    const float *x, *mem; const int* pos;
    const float *w_in, *ret_gn_g, *gmlp_ln_g, *gmlp_ln_b, *gmlp_ws, *gmlp_bs, *w_out, *ln1_g, *ln1_b, *ca_wq, *ca_wkv, *ca_wo, *ln2_g, *ln2_b;
    const float *router_w, *router_bias, *exp_w_gate, *exp_w_up, *exp_w_down, *sh_w_gate, *sh_w_up, *sh_w_down, *ln3_g, *ln3_b;
    float* out; unsigned char* ws;
};

__device__ __forceinline__ int dest_row(int mode, int n) {
    if (mode == 1) { if (n < 1024) { const int d = n & 127; return (n & ~127) + 8 * ((d & 63) >> 2) + 4 * (d >> 6) + (d & 3); } return n; }
    if (mode == 2) return ((n >> 7) << 8) + (n & 127);
    if (mode == 3) return ((n >> 7) << 8) + 128 + (n & 127);
    return n;
}
__device__ __forceinline__ void transpose_item(const float* W, int K, int N, bf16* WT, int mode, float* scr, int item, int lane) {
    const int nblk = N / 32, kb = item / nblk, nb = item % nblk, k0 = 64 * kb, n0 = 32 * nb;
#pragma unroll 8
    for (int i = 0; i < 32; ++i) { const int kk = 2 * i + (lane >> 5); scr[kk * 33 + (lane & 31)] = W[(size_t)(k0 + kk) * N + n0 + (lane & 31)]; }
    asm volatile("s_waitcnt lgkmcnt(0)" ::: "memory");
    const int c = lane & 7;
#pragma unroll
    for (int j = 0; j < 4; ++j) { const int n = (lane >> 3) + 8 * j; const float* s = scr + (8 * c) * 33 + n;
        v4u o; o.x = pk2(s[0 * 33], s[1 * 33]); o.y = pk2(s[2 * 33], s[3 * 33]); o.z = pk2(s[4 * 33], s[5 * 33]); o.w = pk2(s[6 * 33], s[7 * 33]);
        *(v4u*)(WT + (size_t)dest_row(mode, n0 + n) * K + k0 + 8 * c) = o; }
    asm volatile("s_waitcnt lgkmcnt(0)" ::: "memory");
}
template <class PT> __device__ __forceinline__ void prologue_all(const PT& P, int gw, int NGW, int lane, float* scr) {
    unsigned char* ws = P.ws;
    {
        constexpr int I_IN = (1024 / 64) * (3072 / 32), I_SQ = (1024 / 64) * (1024 / 32), I_KV = (1024 / 64) * (2048 / 32), I_R = (1024 / 64) * (256 / 32), I_D = (256 / 64) * (1024 / 32);
        constexpr int NIT = I_IN + 3 * I_SQ + I_KV + I_R + 2 * I_R + I_D;
        for (int it = gw; it < NIT; it += NGW) {
            int r = it;
            if (r < I_IN) { transpose_item(P.w_in, 1024, 3072, (bf16*)(ws + WS_WINT), 1, scr, r, lane); continue; } r -= I_IN;
            if (r < I_SQ) { transpose_item(P.w_out, 1024, 1024, (bf16*)(ws + WS_WOUTT), 0, scr, r, lane); continue; } r -= I_SQ;
            if (r < I_SQ) { transpose_item(P.ca_wq, 1024, 1024, (bf16*)(ws + WS_WQT), 0, scr, r, lane); continue; } r -= I_SQ;
            if (r < I_SQ) { transpose_item(P.ca_wo, 1024, 1024, (bf16*)(ws + WS_WOT), 0, scr, r, lane); continue; } r -= I_SQ;
            if (r < I_KV) { transpose_item(P.ca_wkv, 1024, 2048, (bf16*)(ws + WS_WKVT), 0, scr, r, lane); continue; } r -= I_KV;
            if (r < I_R) { transpose_item(P.router_w, 1024, 256, (bf16*)(ws + WS_WRT), 0, scr, r, lane); continue; } r -= I_R;
            if (r < I_R) { transpose_item(P.sh_w_gate, 1024, 256, (bf16*)(ws + WS_WSH1T), 2, scr, r, lane); continue; } r -= I_R;
            if (r < I_R) { transpose_item(P.sh_w_up, 1024, 256, (bf16*)(ws + WS_WSH1T), 3, scr, r, lane); continue; } r -= I_R;
            transpose_item(P.sh_w_down, 256, 1024, (bf16*)(ws + WS_WSH2T), 0, scr, r, lane);
        }
    }
    {
        constexpr int PER = 128;
        for (int it = gw; it < NE * 3 * PER; it += NGW) {
            const int e = it / (3 * PER), r = it % (3 * PER);
            if (r < PER) transpose_item(P.exp_w_gate + (size_t)e * 1024 * 256, 1024, 256, (bf16*)(ws + WS_W1T) + (size_t)e * 512 * 1024, 2, scr, r, lane);
            else if (r < 2 * PER) transpose_item(P.exp_w_up + (size_t)e * 1024 * 256, 1024, 256, (bf16*)(ws + WS_W1T) + (size_t)e * 512 * 1024, 3, scr, r - PER, lane);
            else transpose_item(P.exp_w_down + (size_t)e * 256 * 1024, 256, 1024, (bf16*)(ws + WS_W2T) + (size_t)e * 1024 * 256, 0, scr, r - 2 * PER, lane);
        }
    }
    {
        const size_t nx8 = (size_t)M * D / 8, nm8 = (size_t)MROWS * D / 8;
        for (size_t i = (size_t)gw * 64 + lane; i < nx8 + nm8; i += (size_t)NGW * 64) {
            const bool isx = i < nx8; const size_t j = isx ? i : i - nx8;
            const f32x4* s = (const f32x4*)((isx ? P.x : P.mem) + j * 8); const f32x4 a = s[0], b = s[1];
            v4u o; o.x = pk2(a.x, a.y); o.y = pk2(a.z, a.w); o.z = pk2(b.x, b.y); o.w = pk2(b.z, b.w);
            *(v4u*)((bf16*)(ws + (isx ? WS_XB : WS_MEMB)) + j * 8) = o;
        }
    }
    {
        float* ct = (float*)(ws + WS_COS); float* st = (float*)(ws + WS_SIN);
        for (size_t i = (size_t)gw * 64 + lane; i < (size_t)M * 64; i += (size_t)NGW * 64) {
            const int m = (int)(i >> 6), d = (int)(i & 63);
            const float inv = exp2f(-(float)d * (13.287712379549449f / 64.f));
            const float ang = (float)P.pos[m] * inv; float s, c; sincosf(ang, &s, &c);
            ct[i] = c; st[i] = s;
        }
    }
    {
        bf16* wm = (bf16*)(ws + WS_WSM);
        for (int i = gw * 64 + lane; i < 4 * 128 * 128; i += NGW * 64) { const int ii = (i >> 7) & 127, jj = i & 127; wm[i] = (bf16)(((jj >> 6) <= (ii >> 6)) ? f2bf(P.gmlp_ws[i]) : 0u); }
    }
}
__device__ __forceinline__ v4u epi_z8(const unsigned char* ws, int m, int c0, const float (&v)[8]) {
    const int sec = c0 >> 9; float o[8];
    if (sec < 2) {
        const int h = (c0 >> 7) & 3, dd0 = ((c0 & 127) >> 3) * 4, il = m & 63;
        const f32x4 cs = *(const f32x4*)((const float*)(ws + WS_COS) + (size_t)m * 64 + dd0), sn = *(const f32x4*)((const float*)(ws + WS_SIN) + (size_t)m * 64 + dd0);
        const float l2g = head_log2g(h);
        const float sc = sec == 0 ? exp2f(l2g * (float)(il + 1)) : 0.08838834764831845f * exp2f(l2g * (float)(63 - il));
#pragma unroll
        for (int t = 0; t < 4; ++t) { const float t1 = v[t], t2 = v[4 + t]; o[t] = (t1 * cs[t] - t2 * sn[t]) * sc; o[4 + t] = (t1 * sn[t] + t2 * cs[t]) * sc; }
    } else if (sec == 2) {
#pragma unroll
        for (int t = 0; t < 8; ++t) o[t] = v[t];
    } else if (sec == 3) {
#pragma unroll
        for (int t = 0; t < 8; ++t) o[t] = silu_f(v[t]);
    } else {
#pragma unroll
        for (int t = 0; t < 8; ++t) o[t] = gelu_f(v[t]);
    }
    v4u w; w.x = pk2(o[0], o[1]); w.y = pk2(o[2], o[3]); w.z = pk2(o[4], o[5]); w.w = pk2(o[6], o[7]); return w;
}

template <int NB, class Prob>
__device__ __forceinline__ void nv_gemm_phase(Prob pr, int K, int ntx, int nty, int ntz, float* lds) {
    float (*As)[132] = (float (*)[132])lds;
    float (*Bs)[16][132] = (float (*)[16][132])(lds + 16 * 132);
    int t = threadIdx.x; asm volatile("" : "+v"(t)); const int tx = t & 15, ty = t >> 4;
    const int nvb = ntx * nty * ntz;
    for (int vb = blockIdx.x; vb < nvb; vb += gridDim.x) {
        const int bz = vb % ntz, by = (vb / ntz) % nty, bx = vb / (ntz * nty);
        if (!pr.setup(bz, by)) continue;
        const int m0 = by * 128, n0 = bx * 128;
        float acc[4][8], acc2[4][8];
#pragma unroll
        for (int i = 0; i < 4; ++i)
#pragma unroll
            for (int j = 0; j < 8; ++j) { acc[i][j] = 0.f; acc2[i][j] = 0.f; }
        const bf16* ap = pr.arow(m0 + (t >> 2)) + (t & 3) * 4;
        const bf16* bp = pr.brow(n0 + (t >> 2)) + (t & 3) * 4;
        const bf16* bp2 = NB == 2 ? pr.brow2(n0 + (t >> 2)) + (t & 3) * 4 : bp;
        for (int k0 = 0; k0 < K; k0 += 16) {
            const v2u a = *(const v2u*)(ap + k0); const v2u b = *(const v2u*)(bp + k0);
            const int r = t >> 2, kk = (t & 3) * 4;
            As[kk][r] = lo16(a.x); As[kk + 1][r] = hi16(a.x); As[kk + 2][r] = lo16(a.y); As[kk + 3][r] = hi16(a.y);
            Bs[0][kk][r] = lo16(b.x); Bs[0][kk + 1][r] = hi16(b.x); Bs[0][kk + 2][r] = lo16(b.y); Bs[0][kk + 3][r] = hi16(b.y);
            if (NB == 2) { const v2u c = *(const v2u*)(bp2 + k0);
                Bs[NB - 1][kk][r] = lo16(c.x); Bs[NB - 1][kk + 1][r] = hi16(c.x); Bs[NB - 1][kk + 2][r] = lo16(c.y); Bs[NB - 1][kk + 3][r] = hi16(c.y); }
            __syncthreads();
#pragma unroll 2
            for (int kq = 0; kq < 16; ++kq) {
                float av[4], bv[8], cv[8];
#pragma unroll
                for (int i = 0; i < 4; ++i) av[i] = As[kq][ty * 4 + i];
#pragma unroll
                for (int j = 0; j < 8; ++j) { bv[j] = Bs[0][kq][tx * 8 + j]; cv[j] = Bs[NB - 1][kq][tx * 8 + j]; }
#pragma unroll
                for (int i = 0; i < 4; ++i)
#pragma unroll
                    for (int j = 0; j < 8; ++j) { acc[i][j] += av[i] * bv[j]; if (NB == 2) acc2[i][j] += av[i] * cv[j]; }
            }
            __syncthreads();
        }
#pragma unroll
        for (int i = 0; i < 4; ++i) pr.epi(m0 + ty * 4 + i, n0 + tx * 8, acc[i], acc2[i]);
    }
}
struct ProbZ {
    const bf16 *A, *Bt; bf16* Z; const unsigned char* ws;
    __device__ bool setup(int, int) { return true; }
    __device__ const bf16* arow(int r) const { return A + (size_t)r * 1024; }
    __device__ const bf16* brow(int n) const { return Bt + (size_t)n * 1024; }
    __device__ const bf16* brow2(int n) const { return nullptr; }
    __device__ void epi(int r, int n0, const float (&a)[8], const float (&)[8]) const { *(v4u*)(Z + (size_t)r * NZ + n0) = epi_z8(ws, r, n0, a); }
};
struct ProbBf {
    const bf16 *A, *Bt; int lda, ldb; bf16* C; int ldc;
    __device__ bool setup(int, int) { return true; }
    __device__ const bf16* arow(int r) const { return A + (size_t)r * lda; }
    __device__ const bf16* brow(int n) const { return Bt + (size_t)n * ldb; }
    __device__ const bf16* brow2(int n) const { return nullptr; }
    __device__ void epi(int r, int n0, const float (&a)[8], const float (&)[8]) const { v4u w; w.x = pk2(a[0], a[1]); w.y = pk2(a[2], a[3]); w.z = pk2(a[4], a[5]); w.w = pk2(a[6], a[7]); *(v4u*)(C + (size_t)r * ldc + n0) = w; }
};
struct ProbF32 {
    const bf16 *A, *Bt; int lda, ldb; float* C; int ldc; int act;
    __device__ bool setup(int, int) { return true; }
    __device__ const bf16* arow(int r) const { return A + (size_t)r * lda; }
    __device__ const bf16* brow(int n) const { return Bt + (size_t)n * ldb; }
    __device__ const bf16* brow2(int n) const { return nullptr; }
    __device__ void epi(int r, int n0, const float (&a)[8], const float (&)[8]) const {
#pragma unroll
        for (int j = 0; j < 8; ++j) C[(size_t)r * ldc + n0 + j] = act ? 1.f / (1.f + __expf(-a[j])) : a[j]; }
};
struct ProbShared {
    const bf16 *A, *Bt; bf16* C;
    __device__ bool setup(int, int) { return true; }
    __device__ const bf16* arow(int r) const { return A + (size_t)r * 1024; }
    __device__ const bf16* brow(int n) const { return Bt + (size_t)dest_row(2, n) * 1024; }
    __device__ const bf16* brow2(int n) const { return Bt + (size_t)dest_row(3, n) * 1024; }
    __device__ void epi(int r, int n0, const float (&a)[8], const float (&b)[8]) const { float o[8];
#pragma unroll
        for (int j = 0; j < 8; ++j) o[j] = silu_f(a[j]) * b[j];
        v4u w; w.x = pk2(o[0], o[1]); w.y = pk2(o[2], o[3]); w.z = pk2(o[4], o[5]); w.w = pk2(o[6], o[7]); *(v4u*)(C + (size_t)r * 256 + n0) = w; }
};
__device__ __forceinline__ int padded_base(const unsigned* cnt, int e) { int s = 0; for (int i = 0; i < e; ++i) s += (int)((cnt[i] + 255u) >> 8) << 8; return s; }
struct ProbExpUp {
    const bf16 *X2, *W1T; bf16* HB; const unsigned* cnt; const int* list; int e, n, pb;
    __device__ bool setup(int bz, int by) { e = bz; n = (int)cnt[e]; if (by * 128 >= n) return false; pb = padded_base(cnt, e); return true; }
    __device__ const bf16* arow(int r) const { const int rr = r < n ? r : 0; return X2 + (size_t)(list[(size_t)e * ECAP + rr] >> 3) * 1024; }
    __device__ const bf16* brow(int nn) const { return W1T + ((size_t)e * 512 + dest_row(2, nn)) * 1024; }
    __device__ const bf16* brow2(int nn) const { return W1T + ((size_t)e * 512 + dest_row(3, nn)) * 1024; }
    __device__ void epi(int r, int n0, const float (&a)[8], const float (&b)[8]) const { float o[8];
#pragma unroll
        for (int j = 0; j < 8; ++j) o[j] = silu_f(a[j]) * b[j];
        v4u w; w.x = pk2(o[0], o[1]); w.y = pk2(o[2], o[3]); w.z = pk2(o[4], o[5]); w.w = pk2(o[6], o[7]); *(v4u*)(HB + (size_t)(pb + r) * 256 + n0) = w; }
};
struct ProbExpDown {
    const bf16 *HB, *W2T; bf16* OB; const unsigned* cnt; const int* list; const float* gate; int e, n, pb;
    __device__ bool setup(int bz, int by) { e = bz; n = (int)cnt[e]; if (by * 128 >= n) return false; pb = padded_base(cnt, e); return true; }
    __device__ const bf16* arow(int r) const { return HB + (size_t)(pb + r) * 256; }
    __device__ const bf16* brow(int nn) const { return W2T + ((size_t)e * 1024 + nn) * 256; }
    __device__ const bf16* brow2(int nn) const { return nullptr; }
    __device__ void epi(int r, int n0, const float (&a)[8], const float (&)[8]) const { if (r >= n) return; const int tk = list[(size_t)e * ECAP + r]; const float g = gate[tk];
        v4u w; w.x = pk2(a[0] * g, a[1] * g); w.y = pk2(a[2] * g, a[3] * g); w.z = pk2(a[4] * g, a[5] * g); w.w = pk2(a[6] * g, a[7] * g); *(v4u*)(OB + (size_t)tk * 1024 + n0) = w; }
};

__device__ __forceinline__ void nv_retention_phase(const bf16* Z, bf16* MIX, const float* gn_g, float* lds) {
    float (*qs)[128] = (float (*)[128])lds; float (*sc)[64] = (float (*)[64])(lds + 32 * 128);
    int t = threadIdx.x; asm volatile("" : "+v"(t));
    for (int vb = blockIdx.x; vb < 64 * 4 * BATCH; vb += gridDim.x) {
        const int i0 = (vb & 63) * 32, h = (vb >> 6) & 3, b = vb >> 8;
        const int ci = i0 >> 6; const size_t rb = (size_t)b * SEQ;
        for (int i = t; i < 32 * 128; i += 512) qs[i >> 7][i & 127] = bf2f(Z[(rb + i0 + (i >> 7)) * NZ + h * 128 + (i & 127)]);
        __syncthreads();
        const float l2g = head_log2g(h);
        const int ii = t >> 4, jq = (t & 15) * 4, dv = (t & 15) * 8;
        float acc[8];
#pragma unroll
        for (int j = 0; j < 8; ++j) acc[j] = 0.f;
        for (int jt = 0; jt <= ci; ++jt) {
#pragma unroll 1
            for (int jj = 0; jj < 4; ++jj) {
                const bf16* kr = Z + (rb + jt * 64 + jq + jj) * NZ + 512 + h * 128; float s = 0.f;
#pragma unroll 2
                for (int d = 0; d < 128; d += 8) { const v4u kv = *(const v4u*)(kr + d);
                    s += qs[ii][d] * lo16(kv.x) + qs[ii][d + 1] * hi16(kv.x) + qs[ii][d + 2] * lo16(kv.y) + qs[ii][d + 3] * hi16(kv.y)
                       + qs[ii][d + 4] * lo16(kv.z) + qs[ii][d + 5] * hi16(kv.z) + qs[ii][d + 6] * lo16(kv.w) + qs[ii][d + 7] * hi16(kv.w); }
                float w;
                if (jt < ci) w = exp2f(l2g * 64.f * (float)(ci - 1 - jt));
                else { const int il = (i0 & 63) + ii, jl = jq + jj; w = exp2f(l2g * (float)(jl <= il ? -64 : 2 * (jl - il) - 64)); }
                sc[ii][jq + jj] = s * w;
            }
            __syncthreads();
#pragma unroll 4
            for (int j = 0; j < 64; ++j) { const float p = sc[ii][j]; const v4u vv = *(const v4u*)(Z + (rb + jt * 64 + j) * NZ + 1024 + h * 128 + dv);
                acc[0] += p * lo16(vv.x); acc[1] += p * hi16(vv.x); acc[2] += p * lo16(vv.y); acc[3] += p * hi16(vv.y);
                acc[4] += p * lo16(vv.z); acc[5] += p * hi16(vv.z); acc[6] += p * lo16(vv.w); acc[7] += p * hi16(vv.w); }
            __syncthreads();
        }
        float s = 0.f;
#pragma unroll
        for (int j = 0; j < 8; ++j) s += acc[j];
        s += __shfl_xor(s, 1); s += __shfl_xor(s, 2); s += __shfl_xor(s, 4); s += __shfl_xor(s, 8);
        const float mean = s * (1.f / 128.f); float q = 0.f;
#pragma unroll
        for (int j = 0; j < 8; ++j) { const float d = acc[j] - mean; q += d * d; }
        q += __shfl_xor(q, 1); q += __shfl_xor(q, 2); q += __shfl_xor(q, 4); q += __shfl_xor(q, 8);
        const float rstd = 1.f / sqrtf(q * (1.f / 128.f) + LN_EPS);
        const size_t row = rb + i0 + ii; const v4u gt = *(const v4u*)(Z + row * NZ + 1536 + h * 128 + dv);
        const float gg[8] = {lo16(gt.x), hi16(gt.x), lo16(gt.y), hi16(gt.y), lo16(gt.z), hi16(gt.z), lo16(gt.w), hi16(gt.w)}; float o[8];
#pragma unroll
        for (int j = 0; j < 8; ++j) o[j] = (acc[j] - mean) * rstd * gn_g[h * 128 + dv + j] * gg[j];
        v4u w; w.x = pk2(o[0], o[1]); w.y = pk2(o[2], o[3]); w.z = pk2(o[4], o[5]); w.w = pk2(o[6], o[7]);
        *(v4u*)(MIX + row * 1024 + h * 128 + dv) = w;
    }
}
__device__ __forceinline__ void nv_gmlp_phase(const bf16* Z, bf16* MIX, const bf16* WsM, const float* ln_g, const float* ln_b, const float* bs, float* lds) {
    bf16 (*vn)[128] = (bf16 (*)[128])lds;
    int t = threadIdx.x; asm volatile("" : "+v"(t)); const int wave = t >> 6, lane = t & 63;
    for (int vb = blockIdx.x; vb < (M / 128) * 4; vb += gridDim.x) {
        const int g = vb & 3; const size_t r0 = (size_t)(vb >> 2) * 128;
        for (int r = wave * 16; r < wave * 16 + 16; ++r) {
            const unsigned w = *(const unsigned*)(Z + (r0 + r) * NZ + 2560 + g * 128 + lane * 2); const float a = lo16(w), b = hi16(w);
            const float mean = wave_sum(a + b) * (1.f / 128.f); const float da = a - mean, db = b - mean; const float rstd = 1.f / sqrtf(wave_sum(da * da + db * db) * (1.f / 128.f) + LN_EPS);
            const int c = g * 128 + lane * 2;
            *(unsigned*)&vn[r][lane * 2] = pk2(da * rstd * ln_g[c] + ln_b[c], db * rstd * ln_g[c + 1] + ln_b[c + 1]);
        }
        __syncthreads();
        const int i = t & 127, ch = t >> 7; const bf16* wr = WsM + ((size_t)g * 128 + i) * 128; const float bi = bs[g * 128 + i];
        for (int cg = 0; cg < 4; ++cg) { const int c = ch * 32 + cg * 8; float acc[8];
#pragma unroll
            for (int j = 0; j < 8; ++j) acc[j] = 0.f;
#pragma unroll 4
            for (int j = 0; j < 128; ++j) { const float w = bf2f(wr[j]); const v4u vv = *(const v4u*)&vn[j][c];
                acc[0] += w * lo16(vv.x); acc[1] += w * hi16(vv.x); acc[2] += w * lo16(vv.y); acc[3] += w * hi16(vv.y);
                acc[4] += w * lo16(vv.z); acc[5] += w * hi16(vv.z); acc[6] += w * lo16(vv.w); acc[7] += w * hi16(vv.w); }
            const v4u uu = *(const v4u*)(Z + (r0 + i) * NZ + 2048 + g * 128 + c);
            const float ug[8] = {lo16(uu.x), hi16(uu.x), lo16(uu.y), hi16(uu.y), lo16(uu.z), hi16(uu.z), lo16(uu.w), hi16(uu.w)}; float o[8];
#pragma unroll
            for (int j = 0; j < 8; ++j) o[j] = ug[j] * (acc[j] + bi);
            v4u w; w.x = pk2(o[0], o[1]); w.y = pk2(o[2], o[3]); w.z = pk2(o[4], o[5]); w.w = pk2(o[6], o[7]);
            *(v4u*)(MIX + (r0 + i) * 1024 + 512 + g * 128 + c) = w; }
        __syncthreads();
    }
}
__device__ __forceinline__ void nv_xattn_phase(const bf16* QC, const bf16* KVM, bf16* OC, float* lds) {
    int t = threadIdx.x; asm volatile("" : "+v"(t)); const int half = t >> 8, tt = t & 255;
    float* qs = lds + half * 256; float* ps = lds + 512 + half * 256; float* red = lds + 1024 + half * 8;
    for (int vb = blockIdx.x; vb < M * 2; vb += gridDim.x) {
        const int m = vb >> 1, h = (vb & 1) * 2 + half, b = m / SEQ;
        qs[tt] = bf2f(QC[(size_t)m * 1024 + h * 256 + tt]);
        __syncthreads();
        const bf16* kr = KVM + ((size_t)b * MEMT + tt) * 2048 + h * 256; float s = 0.f;
#pragma unroll 4
        for (int d = 0; d < 256; d += 8) { const v4u kv = *(const v4u*)(kr + d);
            s += qs[d] * lo16(kv.x) + qs[d + 1] * hi16(kv.x) + qs[d + 2] * lo16(kv.y) + qs[d + 3] * hi16(kv.y) + qs[d + 4] * lo16(kv.z) + qs[d + 5] * hi16(kv.z) + qs[d + 6] * lo16(kv.w) + qs[d + 7] * hi16(kv.w); }
        s *= 0.0625f;
        float mx = s;
#pragma unroll
        for (int o = 1; o < 64; o <<= 1) mx = fmaxf(mx, __shfl_xor(mx, o));
        if ((tt & 63) == 0) red[tt >> 6] = mx;
        __syncthreads();
        mx = fmaxf(fmaxf(red[0], red[1]), fmaxf(red[2], red[3]));
        const float p = __expf(s - mx); const float sm = wave_sum(p);
        if ((tt & 63) == 0) red[4 + (tt >> 6)] = sm;
        ps[tt] = p;
        __syncthreads();
        const float inv = 1.f / (red[4] + red[5] + red[6] + red[7]);
        float acc = 0.f;
#pragma unroll 8
        for (int j = 0; j < 256; ++j) acc += ps[j] * bf2f(KVM[((size_t)b * MEMT + j) * 2048 + 1024 + h * 256 + tt]);
        OC[(size_t)m * 1024 + h * 256 + tt] = (bf16)f2bf(acc * inv);
        __syncthreads();
    }
}
__device__ __forceinline__ void ln_row(const float* T, const bf16* res, const float* g, const float* bb, bf16* out, int m, int lane) {
    f32x4 v[4]; float s = 0.f;
#pragma unroll
    for (int j = 0; j < 4; ++j) { const int c = 4 * lane + 256 * j; const f32x4 a = *(const f32x4*)(T + (size_t)m * 1024 + c); const v2u r = *(const v2u*)(res + (size_t)m * 1024 + c);
        v[j].x = ALPHA * lo16(r.x) + a.x; v[j].y = ALPHA * hi16(r.x) + a.y; v[j].z = ALPHA * lo16(r.y) + a.z; v[j].w = ALPHA * hi16(r.y) + a.w; s += (v[j].x + v[j].y) + (v[j].z + v[j].w); }
    const float mean = wave_sum(s) * (1.f / 1024.f); float q = 0.f;
#pragma unroll
    for (int j = 0; j < 4; ++j) { v[j] = v[j] - mean; q += (v[j].x * v[j].x + v[j].y * v[j].y) + (v[j].z * v[j].z + v[j].w * v[j].w); }
    const float rstd = 1.f / sqrtf(wave_sum(q) * (1.f / 1024.f) + LN_EPS);
#pragma unroll
    for (int j = 0; j < 4; ++j) { const int c = 4 * lane + 256 * j; const f32x4 gg = *(const f32x4*)(g + c), bv = *(const f32x4*)(bb + c);
        v2u o; o.x = pk2(v[j].x * rstd * gg.x + bv.x, v[j].y * rstd * gg.y + bv.y); o.y = pk2(v[j].z * rstd * gg.z + bv.z, v[j].w * rstd * gg.w + bv.w);
        *(v2u*)(out + (size_t)m * 1024 + c) = o; }
}
__device__ __forceinline__ unsigned long long shfl_xor_u64(unsigned long long v, int o) { const unsigned lo = __shfl_xor((unsigned)v, o), hi = __shfl_xor((unsigned)(v >> 32), o); return ((unsigned long long)hi << 32) | lo; }
__device__ __forceinline__ unsigned ford(float f) { const unsigned u = __float_as_uint(f); return (u & 0x80000000u) ? ~u : (u | 0x80000000u); }
__device__ __forceinline__ void route_token(const unsigned char* ws, const float* rbias, int tok, int lane) {
    const float* SC = (const float*)(ws + WS_SC);
    const f32x4 s = *(const f32x4*)(SC + (size_t)tok * 256 + 4 * lane), bi = *(const f32x4*)(rbias + 4 * lane);
    float bv[4] = {s.x + bi.x, s.y + bi.y, s.z + bi.z, s.w + bi.w};
    float m1 = fmaxf(bv[0], bv[1]), m2 = fminf(bv[0], bv[1]);
    { const float c = bv[2]; const float n1 = fmaxf(m1, c); m2 = fmaxf(fminf(m1, c), m2); m1 = n1; }
    { const float c = bv[3]; const float n1 = fmaxf(m1, c); m2 = fmaxf(fminf(m1, c), m2); m1 = n1; }
#pragma unroll
    for (int o = 1; o < 8; o <<= 1) { const float o1 = __shfl_xor(m1, o), o2 = __shfl_xor(m2, o); const float n1 = fmaxf(m1, o1); m2 = fmaxf(fminf(m1, o1), fmaxf(m2, o2)); m1 = n1; }
    const float gs = m1 + m2; const int mygrp = lane >> 3; int rank = 0;
#pragma unroll
    for (int j = 0; j < 8; ++j) { const float o = __shfl(gs, 8 * j); rank += (o > gs || (o == gs && j < mygrp)) ? 1 : 0; }
    const bool sel = rank < 4;
    unsigned long long key[4];
#pragma unroll
    for (int j = 0; j < 4; ++j) key[j] = sel ? (((unsigned long long)ford(bv[j]) << 32) | (unsigned)(255 - (4 * lane + j))) : 0ull;
    int my_e = 0; float my_s = 0.f, ssum = 0.f;
#pragma unroll
    for (int k = 0; k < 8; ++k) {
        unsigned long long best = key[0] > key[1] ? key[0] : key[1]; { const unsigned long long b2 = key[2] > key[3] ? key[2] : key[3]; best = best > b2 ? best : b2; }
#pragma unroll
        for (int o = 1; o < 64; o <<= 1) { const unsigned long long ob = shfl_xor_u64(best, o); best = ob > best ? ob : best; }
        const int e = 255 - (int)(best & 0xffffffffu);
        const float mine = (e & 3) == 0 ? s.x : (e & 3) == 1 ? s.y : (e & 3) == 2 ? s.z : s.w;
        const float se = __shfl(mine, e >> 2);
        ssum += se;
        if (lane == k) { my_e = e; my_s = se; }
#pragma unroll
        for (int j = 0; j < 4; ++j) if (4 * lane + j == e) key[j] = 0ull;
    }
    if (lane < 8) {
        unsigned* cnt = (unsigned*)(ws + WS_CTL) + CW_CNT;
        const unsigned pos = atomicAdd(cnt + my_e, 1u);
        ((int*)(ws + WS_LIST))[(size_t)my_e * ECAP + pos] = tok * 8 + lane;
        ((int*)(ws + WS_EIDX))[tok * 8 + lane] = my_e;
        ((float*)(ws + WS_GATE))[tok * 8 + lane] = my_s / ssum * ROUTED_SCALE;
    }
}
__device__ __forceinline__ void combine_token(const unsigned char* ws, const float* g, const float* bb, float* out, int m, int lane) {
    const bf16* X2 = (const bf16*)(ws + WS_X2); const bf16* YS = (const bf16*)(ws + WS_YS); const bf16* OB = (const bf16*)(ws + WS_OB);
    f32x4 v[4]; float s = 0.f;
#pragma unroll
    for (int j = 0; j < 4; ++j) { const int c = 4 * lane + 256 * j; const v2u r = *(const v2u*)(X2 + (size_t)m * 1024 + c), y = *(const v2u*)(YS + (size_t)m * 1024 + c);
        f32x4 a; a.x = ALPHA * lo16(r.x) + lo16(y.x); a.y = ALPHA * hi16(r.x) + hi16(y.x); a.z = ALPHA * lo16(r.y) + lo16(y.y); a.w = ALPHA * hi16(r.y) + hi16(y.y);
#pragma unroll
        for (int k = 0; k < 8; ++k) { const v2u o = *(const v2u*)(OB + ((size_t)m * 8 + k) * 1024 + c); a.x += lo16(o.x); a.y += hi16(o.x); a.z += lo16(o.y); a.w += hi16(o.y); }
        v[j] = a; s += (a.x + a.y) + (a.z + a.w); }
    const float mean = wave_sum(s) * (1.f / 1024.f); float q = 0.f;
#pragma unroll
    for (int j = 0; j < 4; ++j) { v[j] = v[j] - mean; q += (v[j].x * v[j].x + v[j].y * v[j].y) + (v[j].z * v[j].z + v[j].w * v[j].w); }
    const float rstd = 1.f / sqrtf(wave_sum(q) * (1.f / 1024.f) + LN_EPS);
#pragma unroll
    for (int j = 0; j < 4; ++j) { const int c = 4 * lane + 256 * j; const f32x4 gg = *(const f32x4*)(g + c), bv = *(const f32x4*)(bb + c);
        f32x4 o; o.x = v[j].x * rstd * gg.x + bv.x; o.y = v[j].y * rstd * gg.y + bv.y; o.z = v[j].z * rstd * gg.z + bv.z; o.w = v[j].w * rstd * gg.w + bv.w;
        *(f32x4*)(out + (size_t)m * 1024 + c) = o; }
}

#define LAS __attribute__((address_space(3)))
#define XB_TMO      128
#define XB_XCNT(j)  (256  + 64 * (j))
#define XB_XSUB(j)  (1280 + 64 * (j))
#define XB_XGEN(j)  (2304 + 64 * (j))
#define XB_TOP      3328
#define XB_TOPGEN   3392
#define XCD_BAR_WORDS 3456
#define XB_SPIN_CAP (1u << 18)
__device__ __forceinline__ unsigned xb_ld(unsigned* p)              { return __hip_atomic_load(p, __ATOMIC_RELAXED, __HIP_MEMORY_SCOPE_AGENT); }
__device__ __forceinline__ unsigned xb_add(unsigned* p, unsigned v) { return __hip_atomic_fetch_add(p, v, __ATOMIC_RELAXED, __HIP_MEMORY_SCOPE_AGENT); }
__device__ __forceinline__ unsigned xb_xcc_id() { return (unsigned)__builtin_amdgcn_s_getreg((3 << 11) | 20) & 0xFu; }
#define XB_SPIN(cond, bar) do { unsigned _sp = 0; while (cond) { __builtin_amdgcn_s_sleep(1); \
    if ((++_sp & 255u) == 0u) { if (xb_ld(&(bar)[XB_TMO])) break; if (_sp > XB_SPIN_CAP) { atomicAdd(&(bar)[XB_TMO], 1u); break; } } } } while (0)
struct XcdBarrier { unsigned* bar; unsigned x; volatile LAS unsigned* st; };
__device__ __forceinline__ XcdBarrier xcd_barrier_post(unsigned* bar, volatile LAS unsigned* st) {
    XcdBarrier b; b.bar = bar; b.x = xb_xcc_id(); b.st = st;
    if (threadIdx.x == 0) (void)xb_add(&bar[XB_XCNT(b.x)], 1u);
    return b;
}
__device__ __forceinline__ void xcd_barrier_complete(unsigned* bar, unsigned x, unsigned& nloc, unsigned& nx) {
    const unsigned G = gridDim.x * gridDim.y * gridDim.z;
    unsigned sum, cnt, mine, sp = 0u;
    for (;;) {
        sum = 0u; cnt = 0u; mine = 0u;
#pragma unroll
        for (unsigned j = 0; j < 16; ++j) { const unsigned c = xb_ld(&bar[XB_XCNT(j)]); sum += c; cnt += (c > 0u) ? 1u : 0u; mine = (j == x) ? c : mine; }
        if (sum == G) break;
        __builtin_amdgcn_s_sleep(1);
        if ((++sp & 255u) == 0u) { if (xb_ld(&bar[XB_TMO])) break; if (sp > XB_SPIN_CAP) { atomicAdd(&bar[XB_TMO], 1u); break; } }
    }
    nloc = mine > 0u ? mine : 1u; nx = cnt > 0u ? cnt : 1u;
}
__device__ __forceinline__ void xcd_barrier(const XcdBarrier& b) {
    asm volatile("s_waitcnt vmcnt(0)" ::: "memory");
    __syncthreads();
    if (threadIdx.x == 0) {
        unsigned* bar = b.bar;
        __builtin_amdgcn_s_waitcnt(0);
        unsigned nloc = b.st[0], nx = b.st[1];
        if (nloc == 0u) { xcd_barrier_complete(bar, b.x, nloc, nx); b.st[0] = nloc; b.st[1] = nx; }
        const unsigned old = xb_add(&bar[XB_XSUB(b.x)], 1u);
        const unsigned gen = old / nloc;
        if (old + 1u == (gen + 1u) * nloc) {
            __builtin_amdgcn_fence(__ATOMIC_RELEASE, "agent");
            asm volatile("s_waitcnt vmcnt(0)" ::: "memory");
            const unsigned og = xb_add(&bar[XB_TOP], 1u);
            const unsigned tg = og / nx;
            if (og + 1u == (tg + 1u) * nx) xb_add(&bar[XB_TOPGEN], 1u);
            else XB_SPIN(xb_ld(&bar[XB_TOPGEN]) == tg, bar);
            __builtin_amdgcn_fence(__ATOMIC_ACQUIRE, "agent");
            xb_add(&bar[XB_XGEN(b.x)], 1u);
            asm volatile("s_waitcnt vmcnt(0)" ::: "memory");
        } else {
            XB_SPIN(xb_ld(&bar[XB_XGEN(b.x)]) == gen, bar);
            __builtin_amdgcn_fence(__ATOMIC_ACQUIRE, "agent");
            asm volatile("s_waitcnt vmcnt(0)" ::: "memory");
        }
    }
    __syncthreads();
}

constexpr int NWAVES = 8;
constexpr int RING_BYTES = 131072, LDSCTL_OFF = RING_BYTES, MISC_OFF = LDSCTL_OFF + 320, LDS_BYTES = 147456;
constexpr int CW_BAR = 4096;
struct Args { Ptrs P; int ph_lo, ph_hi; };
typedef const Args __attribute__((address_space(4)))* KArgP;
__device__ __forceinline__ KArgP kargs() { KArgP p = (KArgP)__builtin_amdgcn_kernarg_segment_ptr(); asm volatile("" : "+s"(p)); return p; }
#define WSP(T, off) ((T*)(ws + (off)))
__global__ void __launch_bounds__(NWAVES * 64, 2) mk_fwd(Args args) {
    extern __shared__ __attribute__((aligned(16))) unsigned char lds[];
    const int lo = args.ph_lo, hi = args.ph_hi;
    { const int tid = threadIdx.x; for (int u = tid; u < (LDS_BYTES - LDSCTL_OFF) / 4; u += NWAVES * 64) ((unsigned*)(lds + LDSCTL_OFF))[u] = 0u; }
    __syncthreads();
    XcdBarrier bar = xcd_barrier_post((unsigned*)(args.P.ws + WS_CTL) + CW_BAR, (volatile LAS unsigned*)(lds + MISC_OFF) + 8);
    float* fl = (float*)lds;
#ifndef PHMASK
#define PHMASK 0xfff
#endif
#define IN(k) (((PHMASK >> (k)) & 1) && lo <= (k) && (k) < hi)
#define SEAM(k) do { if (IN(k) && IN((k) + 1)) xcd_barrier(bar); } while (0)
#define PHASE_VARS KArgP ka = kargs(); unsigned char* ws = ka->P.ws; int tid = threadIdx.x; asm volatile("" : "+v"(tid)); const int lane = tid & 63, wave = __builtin_amdgcn_readfirstlane(tid >> 6); \
    const int gw = blockIdx.x * NWAVES + wave, NGW = gridDim.x * NWAVES; (void)lane; (void)gw; (void)NGW; (void)ws

    if (IN(0)) { PHASE_VARS; prologue_all(ka->P, gw, NGW, lane, fl + wave * 4096); } SEAM(0);
    if (IN(1)) { PHASE_VARS; nv_gemm_phase<1, ProbZ>(ProbZ{WSP(const bf16, WS_XB), WSP(const bf16, WS_WINT), WSP(bf16, WS_Z), ws}, 1024, NZ / 128, M / 128, 1, fl); } SEAM(1);
    if (IN(2)) { PHASE_VARS;
        nv_gemm_phase<1, ProbBf>(ProbBf{WSP(const bf16, WS_MEMB), WSP(const bf16, WS_WKVT), 1024, 1024, WSP(bf16, WS_KVM), 2048}, 1024, 2048 / 128, MROWS / 128, 1, fl);
        nv_retention_phase(WSP(const bf16, WS_Z), WSP(bf16, WS_MIX), ka->P.ret_gn_g, fl);
        nv_gmlp_phase(WSP(const bf16, WS_Z), WSP(bf16, WS_MIX), WSP(const bf16, WS_WSM), ka->P.gmlp_ln_g, ka->P.gmlp_ln_b, ka->P.gmlp_bs, fl);
    } SEAM(2);
    if (IN(3)) { PHASE_VARS;
        nv_gemm_phase<1, ProbF32>(ProbF32{WSP(const bf16, WS_MIX), WSP(const bf16, WS_WOUTT), 1024, 1024, WSP(float, WS_T32), 1024, 0}, 1024, 1024 / 128, M / 128, 1, fl);
        xcd_barrier(bar);
        for (int m = gw; m < M; m += NGW) ln_row(WSP(const float, WS_T32), WSP(const bf16, WS_XB), ka->P.ln1_g, ka->P.ln1_b, WSP(bf16, WS_X1), m, lane);
    } SEAM(3);
    if (IN(4)) { PHASE_VARS; nv_gemm_phase<1, ProbBf>(ProbBf{WSP(const bf16, WS_X1), WSP(const bf16, WS_WQT), 1024, 1024, WSP(bf16, WS_QC), 1024}, 1024, 1024 / 128, M / 128, 1, fl); } SEAM(4);
    if (IN(5)) { PHASE_VARS; nv_xattn_phase(WSP(const bf16, WS_QC), WSP(const bf16, WS_KVM), WSP(bf16, WS_OC), fl); } SEAM(5);
    if (IN(6)) { PHASE_VARS;
        nv_gemm_phase<1, ProbF32>(ProbF32{WSP(const bf16, WS_OC), WSP(const bf16, WS_WOT), 1024, 1024, WSP(float, WS_T32), 1024, 0}, 1024, 1024 / 128, M / 128, 1, fl);
        xcd_barrier(bar);
        for (int m = gw; m < M; m += NGW) ln_row(WSP(const float, WS_T32), WSP(const bf16, WS_X1), ka->P.ln2_g, ka->P.ln2_b, WSP(bf16, WS_X2), m, lane);
    } SEAM(6);
    if (IN(7)) { PHASE_VARS;
        nv_gemm_phase<1, ProbF32>(ProbF32{WSP(const bf16, WS_X2), WSP(const bf16, WS_WRT), 1024, 1024, WSP(float, WS_SC), 256, 1}, 1024, 256 / 128, M / 128, 1, fl);
        nv_gemm_phase<2, ProbShared>(ProbShared{WSP(const bf16, WS_X2), WSP(const bf16, WS_WSH1T), WSP(bf16, WS_HS)}, 1024, 256 / 128, M / 128, 1, fl);
    } SEAM(7);
    if (IN(8)) { PHASE_VARS;
        for (int m = gw; m < M; m += NGW) route_token(ws, ka->P.router_bias, m, lane);
        nv_gemm_phase<1, ProbBf>(ProbBf{WSP(const bf16, WS_HS), WSP(const bf16, WS_WSH2T), 256, 256, WSP(bf16, WS_YS), 1024}, 256, 1024 / 128, M / 128, 1, fl);
    } SEAM(8);
    if (IN(9)) { PHASE_VARS; nv_gemm_phase<2, ProbExpUp>(ProbExpUp{WSP(const bf16, WS_X2), WSP(const bf16, WS_W1T), WSP(bf16, WS_HB), WSP(const unsigned, WS_CTL) + CW_CNT, WSP(const int, WS_LIST), 0, 0, 0}, 1024, 256 / 128, ECAP / 128, NE, fl); } SEAM(9);
    if (IN(10)) { PHASE_VARS; nv_gemm_phase<1, ProbExpDown>(ProbExpDown{WSP(const bf16, WS_HB), WSP(const bf16, WS_W2T), WSP(bf16, WS_OB), WSP(const unsigned, WS_CTL) + CW_CNT, WSP(const int, WS_LIST), WSP(const float, WS_GATE), 0, 0, 0}, 256, 1024 / 128, ECAP / 128, NE, fl); } SEAM(10);
    if (IN(11)) { PHASE_VARS; for (int m = gw; m < M; m += NGW) combine_token(ws, ka->P.ln3_g, ka->P.ln3_b, ka->P.out, m, lane); }
#undef IN
#undef SEAM
}

extern "C" void kernel_launch(void* const* d_in, const int* in_sizes, int n_in, void* d_out, int out_size, void* d_ws, size_t ws_size, hipStream_t stream) {
    static int grid = 0;
    if (grid == 0) {
        if (n_in != 27 || in_sizes[0] != M * D || out_size != M * D || ws_size < WS_END) { fprintf(stderr, "kernel_launch: unexpected shapes: n_in %d in0 %d out %d ws %zu (need %zu)\n", n_in, n_in > 0 ? in_sizes[0] : -1, out_size, ws_size, (size_t)WS_END); grid = -1; return; }
        int dev = 0, cus = 0, per_cu = 0;
        if (hipGetDevice(&dev) != hipSuccess || hipDeviceGetAttribute(&cus, hipDeviceAttributeMultiprocessorCount, dev) != hipSuccess) { grid = -1; return; }
        if (hipFuncSetAttribute((const void*)mk_fwd, hipFuncAttributeMaxDynamicSharedMemorySize, LDS_BYTES) != hipSuccess) { fprintf(stderr, "kernel_launch: hipFuncSetAttribute failed\n"); grid = -1; return; }
        if (hipOccupancyMaxActiveBlocksPerMultiprocessor(&per_cu, (const void*)mk_fwd, NWAVES * 64, LDS_BYTES) != hipSuccess || per_cu < 1) fprintf(stderr, "kernel_launch: occupancy query says %d\n", per_cu);
        (void)hipGetLastError();
        grid = cus < 256 ? cus : 256;
    }
    if (grid < 0) return;
    Args a{};
    Ptrs& P = a.P;
    P.x = (const float*)d_in[0]; P.mem = (const float*)d_in[1]; P.pos = (const int*)d_in[2];
    P.w_in = (const float*)d_in[3]; P.ret_gn_g = (const float*)d_in[4]; P.gmlp_ln_g = (const float*)d_in[5]; P.gmlp_ln_b = (const float*)d_in[6]; P.gmlp_ws = (const float*)d_in[7]; P.gmlp_bs = (const float*)d_in[8];
    P.w_out = (const float*)d_in[9]; P.ln1_g = (const float*)d_in[10]; P.ln1_b = (const float*)d_in[11]; P.ca_wq = (const float*)d_in[12]; P.ca_wkv = (const float*)d_in[13]; P.ca_wo = (const float*)d_in[14];
    P.ln2_g = (const float*)d_in[15]; P.ln2_b = (const float*)d_in[16]; P.router_w = (const float*)d_in[17]; P.router_bias = (const float*)d_in[18];
    P.exp_w_gate = (const float*)d_in[19]; P.exp_w_up = (const float*)d_in[20]; P.exp_w_down = (const float*)d_in[21]; P.sh_w_gate = (const float*)d_in[22]; P.sh_w_up = (const float*)d_in[23]; P.sh_w_down = (const float*)d_in[24];
    P.ln3_g = (const float*)d_in[25]; P.ln3_b = (const float*)d_in[26]; P.out = (float*)d_out; P.ws = (unsigned char*)d_ws;
    (void)hipMemsetAsync((unsigned char*)d_ws + WS_CTL, 0, CTL_ZERO_BYTES, stream);
    a.ph_lo = 0; a.ph_hi = 12;
    hipLaunchKernelGGL(mk_fwd, dim3(grid), dim3(NWAVES * 64), LDS_BYTES, stream, a);
    const hipError_t le = hipPeekAtLastError();
    if (le != hipSuccess) fprintf(stderr, "kernel_launch: launch failed: %s\n", hipGetErrorName(le));
}
```
